# Optimizing an MI355X kernel written in HIP

```python
import math
import jax, jax.numpy as jnp
from jax import lax
import numpy as np

D_MODEL = 2048
BATCH = 1
SEQ = 8192
DEPTH = 1

D_MIX = D_MODEL
D_ATTN = D_MIX // 2
D_CONV = D_MIX - D_ATTN
HEAD_DIM = 128
N_HEADS = D_ATTN // HEAD_DIM
CONV_GROUPS = 8
MOBA_BLOCK = 256
MOBA_TOPK = 3
QUERY_CHUNK = 64
CONV_WIDTH = 31
N_EXPERTS = 32
TOP_K = 4
D_FF = D_MODEL
SWIGLU_ALPHA = 1.702
SWIGLU_LIMIT = 7.0
ROUTE_BLOCK = 128
LN_EPS = 1e-5
DEEPNORM_ALPHA = (2.0 * DEPTH) ** 0.25
DEEPNORM_BETA = (8.0 * DEPTH) ** -0.25
IN_COLS = 3 * D_ATTN + 2 * D_CONV

kernel_name = "hybrid_moba_conformer_moe_deepnorm"


def layer_norm(x, g, b):
    xf = x.astype(jnp.float32)
    mu = jnp.mean(xf, axis=-1, keepdims=True)
    var = jnp.mean(jnp.square(xf - mu), axis=-1, keepdims=True)
    y = (xf - mu) * lax.rsqrt(var + LN_EPS) * g.astype(jnp.float32) + b.astype(jnp.float32)
    return y.astype(x.dtype)


def alibi_slopes(n_heads):
    return 2.0 ** (-(8.0 / n_heads) * jnp.arange(1, n_heads + 1, dtype=jnp.float32))


def moba_attention(q, k, v):
    B, S, H, hd = q.shape
    blk = MOBA_BLOCK
    nb = -(-S // blk)
    s_pad = nb * blk
    pad = ((0, 0), (0, s_pad - S), (0, 0), (0, 0))
    kb = jnp.pad(k, pad).reshape(B, nb, blk, H, hd).transpose(0, 3, 1, 2, 4)
    vb = jnp.pad(v, pad).reshape(B, nb, blk, H, hd).transpose(0, 3, 1, 2, 4)
    k_mean = jnp.mean(kb.astype(jnp.float32), axis=3)

    q_blk = jnp.arange(S) // blk
    gate = jnp.einsum('bshd,bhnd->bhsn', q.astype(jnp.float32), k_mean)
    fully_past = jnp.arange(nb)[None, :] < q_blk[:, None]
    gate = jnp.where(fully_past[None, None], gate, -jnp.inf)
    n_sel = min(MOBA_TOPK, nb)
    sel_score, sel = lax.top_k(gate, n_sel)
    sel_valid = sel_score > -jnp.inf

    qh = q.transpose(0, 2, 1, 3)
    slopes = alibi_slopes(H)
    scale = hd ** -0.5
    b_ix = jnp.arange(B)[:, None, None, None]
    h_ix = jnp.arange(H)[None, :, None, None]
    qc = QUERY_CHUNK

    def chunk(c):
        t0 = c * qc
        q_c = lax.dynamic_slice_in_dim(qh, t0, qc, axis=2)
        sel_c = lax.dynamic_slice_in_dim(sel, t0, qc, axis=2)
        val_c = lax.dynamic_slice_in_dim(sel_valid, t0, qc, axis=2)
        t = t0 + jnp.arange(qc)
        k_sel = kb[b_ix, h_ix, sel_c]
        v_sel = vb[b_ix, h_ix, sel_c]
        s_sel = jnp.einsum('bhqd,bhqnkd->bhqnk', q_c, k_sel).astype(jnp.float32) * scale
        pos_sel = sel_c[..., None] * blk + jnp.arange(blk)
        dist_sel = (t[None, None, :, None, None] - pos_sel).astype(jnp.float32)
        s_sel = s_sel - slopes[None, :, None, None, None] * dist_sel
        s_sel = jnp.where(val_c[..., None], s_sel, -jnp.inf)
        own = t0 // blk
        k_own = lax.dynamic_index_in_dim(kb, own, axis=2, keepdims=False)
        v_own = lax.dynamic_index_in_dim(vb, own, axis=2, keepdims=False)
        s_own = jnp.einsum('bhqd,bhkd->bhqk', q_c, k_own).astype(jnp.float32) * scale
        dist_own = t[:, None] - (own * blk + jnp.arange(blk))[None, :]
        s_own = jnp.where(dist_own[None, None] >= 0,
                          s_own - slopes[None, :, None, None] * dist_own.astype(jnp.float32)[None, None],
                          -jnp.inf)
        scores = jnp.concatenate([s_sel.reshape(B, H, qc, n_sel * blk), s_own], axis=-1)
        p = jax.nn.softmax(scores, axis=-1).astype(v.dtype)
        p_sel = p[..., :n_sel * blk].reshape(B, H, qc, n_sel, blk)
        p_own = p[..., n_sel * blk:]
        return (jnp.einsum('bhqnk,bhqnkd->bhqd', p_sel, v_sel)
                + jnp.einsum('bhqk,bhkd->bhqd', p_own, v_own))

    outs = lax.map(chunk, jnp.arange(S // qc))
    return outs.transpose(1, 0, 3, 2, 4).reshape(B, S, H * hd)


def conformer_conv(ga, gb, conv_w, conv_b, conv_ln_g, conv_ln_b):
    u = ga * jax.nn.sigmoid(gb)
    c = lax.conv_general_dilated(
        u, conv_w[:, None, :], window_strides=(1,), padding=[(CONV_WIDTH - 1, 0)],
        dimension_numbers=('NWC', 'WIO', 'NWC'), feature_group_count=u.shape[-1]) + conv_b
    c = layer_norm(c, conv_ln_g, conv_ln_b)
    return c * jax.nn.sigmoid(c)


def moe_ffn(h, w_router, b_router, w_gate_up, b_gate_up, w_down, b_down):
    B, S, D = h.shape
    T = B * S
    xt = h.reshape(T, D)
    logits = (xt @ w_router + b_router).astype(jnp.float32)
    top_val, top_idx = lax.top_k(logits, TOP_K)
    gates = jax.nn.softmax(top_val, axis=-1)
    A = T * TOP_K
    flat_e = top_idx.reshape(A)
    flat_tok = jnp.arange(A, dtype=jnp.int32) // TOP_K
    flat_g = gates.reshape(A)
    order = jnp.argsort(flat_e)
    e_sorted = flat_e[order]
    counts = jnp.bincount(flat_e, length=N_EXPERTS)
    starts = jnp.cumsum(counts) - counts
    padded = ((counts + ROUTE_BLOCK - 1) // ROUTE_BLOCK) * ROUTE_BLOCK
    pad_end = jnp.cumsum(padded)
    pad_start = pad_end - padded
    dest = pad_start[e_sorted] + (jnp.arange(A) - starts[e_sorted])
    n_blocks = -(-A // ROUTE_BLOCK) + N_EXPERTS
    cap = n_blocks * ROUTE_BLOCK
    row_tok = jnp.zeros((cap,), jnp.int32).at[dest].set(flat_tok[order])
    row_gate = jnp.zeros((cap,), h.dtype).at[dest].set(flat_g[order].astype(h.dtype))
    block_e = jnp.minimum(
        jnp.searchsorted(pad_end, jnp.arange(n_blocks) * ROUTE_BLOCK, side='right'),
        N_EXPERTS - 1)

    def run_block(args):
        tok, e = args
        xb = xt[tok]
        gu = xb @ w_gate_up[e] + b_gate_up[e]
        g, u = gu[:, :D_FF], gu[:, D_FF:]
        g = jnp.minimum(g, SWIGLU_LIMIT)
        u = jnp.clip(u, -SWIGLU_LIMIT, SWIGLU_LIMIT)
        act = (u + 1.0) * (g * jax.nn.sigmoid(SWIGLU_ALPHA * g))
        return act @ w_down[e] + b_down[e]

    y_rows = lax.map(run_block, (row_tok.reshape(n_blocks, ROUTE_BLOCK), block_e))
    y = jax.ops.segment_sum(y_rows.reshape(cap, D) * row_gate[:, None], row_tok, num_segments=T)
    return y.reshape(B, S, D)


def setup_inputs(seed: int = 0) -> dict:
    key = jax.random.key(seed)
    ks = jax.random.split(key, 24)
    f32 = jnp.float32
    nrm = lambda k, shape, s: jax.random.normal(k, shape, f32) * s
    d_in = D_MODEL ** -0.5
    w_q = nrm(ks[1], (D_MODEL, D_ATTN), d_in)
    w_k = nrm(ks[2], (D_MODEL, D_ATTN), d_in)
    w_v = nrm(ks[3], (D_MODEL, D_ATTN), d_in * DEEPNORM_BETA)
    w_ga = nrm(ks[4], (D_MODEL, D_CONV), d_in)
    w_gb = nrm(ks[5], (D_MODEL, D_CONV), d_in)
    return {
        "x": jax.random.normal(ks[0], (BATCH, SEQ, D_MODEL), f32),
        "w_in": jnp.concatenate([w_q, w_k, w_v, w_ga, w_gb], axis=1),
        "conv_w": nrm(ks[6], (CONV_WIDTH, D_CONV), CONV_WIDTH ** -0.5),
        "conv_b": nrm(ks[7], (D_CONV,), 0.01),
        "conv_ln_g": 1.0 + nrm(ks[8], (D_CONV,), 0.01),
        "conv_ln_b": nrm(ks[9], (D_CONV,), 0.01),
        "w_out": nrm(ks[10], (D_MIX, D_MODEL), D_MIX ** -0.5 * DEEPNORM_BETA),
        "ln1_g": 1.0 + nrm(ks[11], (D_MODEL,), 0.01),
        "ln1_b": nrm(ks[12], (D_MODEL,), 0.01),
        "w_router": nrm(ks[13], (D_MODEL, N_EXPERTS), d_in),
        "b_router": nrm(ks[14], (N_EXPERTS,), 0.01),
        "w_gate_up": nrm(ks[15], (N_EXPERTS, D_MODEL, 2 * D_FF), d_in * DEEPNORM_BETA),
        "b_gate_up": nrm(ks[16], (N_EXPERTS, 2 * D_FF), 0.01),
        "w_down": nrm(ks[17], (N_EXPERTS, D_FF, D_MODEL), D_FF ** -0.5 * DEEPNORM_BETA),
        "b_down": nrm(ks[18], (N_EXPERTS, D_MODEL), 0.01),
        "ln2_g": 1.0 + nrm(ks[19], (D_MODEL,), 0.01),
        "ln2_b": nrm(ks[20], (D_MODEL,), 0.01),
    }


def reference(x, w_in, conv_w, conv_b, conv_ln_g, conv_ln_b, w_out, ln1_g, ln1_b,
              w_router, b_router, w_gate_up, b_gate_up, w_down, b_down, ln2_g, ln2_b):
    B, S, _ = x.shape
    h = x
    for _layer in range(DEPTH):
        proj = h @ w_in
        q, k, v, ga, gb = jnp.split(
            proj, [D_ATTN, 2 * D_ATTN, 3 * D_ATTN, 3 * D_ATTN + D_CONV], axis=-1)
        q = q.reshape(B, S, N_HEADS, HEAD_DIM)
        k = k.reshape(B, S, N_HEADS, HEAD_DIM)
        v = v.reshape(B, S, N_HEADS, HEAD_DIM)
        attn = moba_attention(q, k, v)
        conv = conformer_conv(ga, gb, conv_w, conv_b, conv_ln_g, conv_ln_b)
        mix = jnp.concatenate([attn, conv], axis=-1) @ w_out
        h = layer_norm(DEEPNORM_ALPHA * h + mix, ln1_g, ln1_b)
        ffn = moe_ffn(h, w_router, b_router, w_gate_up, b_gate_up, w_down, b_down)
        h = layer_norm(DEEPNORM_ALPHA * h + ffn, ln2_g, ln2_b)
    return h
```

```cpp
#include <hip/hip_runtime.h>
#include <cstdio>
#include <cstdint>

#ifndef MK_N_LAUNCHES
#define MK_N_LAUNCHES 1
#endif

#define GAS __attribute__((address_space(1)))
#define LAS __attribute__((address_space(3)))
typedef unsigned short bf16_t;
typedef short bf16x8 __attribute__((ext_vector_type(8)));
typedef short s16x4 __attribute__((ext_vector_type(4)));
typedef float f32x4 __attribute__((ext_vector_type(4)));
typedef float f32x2 __attribute__((ext_vector_type(2)));
typedef float f32x16 __attribute__((ext_vector_type(16)));
typedef unsigned u32x4 __attribute__((ext_vector_type(4)));
typedef unsigned u32x2 __attribute__((ext_vector_type(2)));

constexpr int S = 8192, DM = 2048, DA = 1024, DC = 1024, NH = 8, HD = 128, NBLK = 32, BLK = 256;
constexpr int NE = 32, DFF = 2048, INCOLS = 5120, CONVW = 31;
constexpr int ECAP = 8192;
constexpr float LN_EPS = 1e-5f;
constexpr float DN_ALPHA = 1.189207115002721f;
constexpr float SC_W = 64.f, SC_H = 8.f, SC_ACT = 4.f, SC_Y = 64.f;
constexpr int NWAVES = 8, NTHR = 512;
constexpr int NPHASE = 10;

constexpr size_t MiB = 1u << 20;
constexpr size_t WS_CTL = 0, CTL_ZERO_BYTES = 1 * MiB;
constexpr size_t WS_XB = 1 * MiB;
constexpr size_t WS_WINT = 33 * MiB;
constexpr size_t WS_WOUTT = 53 * MiB;
constexpr size_t WS_QB = 61 * MiB;
constexpr size_t WS_KB = 77 * MiB;
constexpr size_t WS_VB = 93 * MiB;
constexpr size_t WS_UB = 109 * MiB;
constexpr size_t WS_ALIST = 125 * MiB;
constexpr size_t WS_LSE = 133 * MiB;
constexpr size_t WS_OPART = 134 * MiB;
constexpr size_t WS_MIXIN = 198 * MiB;
constexpr size_t WS_H1 = 230 * MiB;
constexpr size_t WS_TOKROW = 294 * MiB;
constexpr size_t WS_GATE = 295 * MiB;
constexpr size_t WS_WGUT = 296 * MiB;
constexpr size_t WS_WDT = 808 * MiB;
constexpr size_t WS_XG = 1064 * MiB;
constexpr size_t WS_ACT = 2088 * MiB;
constexpr size_t WS_H1B = 3112 * MiB;
constexpr size_t WS_WRT = 3144 * MiB;
constexpr size_t WS_TOKLIST = 3145 * MiB;
constexpr size_t WS_H8 = 3146 * MiB;
constexpr size_t WS_IDLIST = 3162 * MiB;
constexpr size_t WS_END = 3163 * MiB;
constexpr int CW_BAR = 4096;
constexpr int CW_ECNT = 8192;
constexpr int CW_CQ = 12416, CW_READY = 12480;
constexpr int CW_GQ = 49152;
constexpr int CW_AQ = 12288;
constexpr int CW_ECNT2 = 10240, CW_ACNT2 = 32768;
constexpr int CW_ACNT = 16384;
constexpr size_t CTL_KSUM = 262144;

constexpr int RING_BYTES = 131072;
constexpr int MISC_OFF = RING_BYTES;
constexpr int LDS_BYTES = RING_BYTES + 12288;

__device__ __forceinline__ unsigned cvt_pk_bf16(float lo, float hi) { unsigned r; asm volatile("v_cvt_pk_bf16_f32 %0, %1, %2" : "=v"(r) : "v"(lo), "v"(hi)); return r; }
__device__ __forceinline__ unsigned cvt4_fp8(float a, float b, float c, float d) {
    a = __builtin_amdgcn_fmed3f(a, -448.f, 448.f); b = __builtin_amdgcn_fmed3f(b, -448.f, 448.f); c = __builtin_amdgcn_fmed3f(c, -448.f, 448.f); d = __builtin_amdgcn_fmed3f(d, -448.f, 448.f);
    int w = __builtin_amdgcn_cvt_pk_fp8_f32(a, b, 0, false); w = __builtin_amdgcn_cvt_pk_fp8_f32(c, d, w, true); return (unsigned)w; }
__device__ __forceinline__ float bf_lo(unsigned w) { return __builtin_bit_cast(float, w << 16); }
__device__ __forceinline__ float bf_hi(unsigned w) { return __builtin_bit_cast(float, w & 0xffff0000u); }
__device__ __forceinline__ float wave_sum(float v) {
#pragma unroll
    for (int o = 1; o < 64; o <<= 1) v += __shfl_xor(v, o);
    return v;
}
__device__ __forceinline__ float fast_sigmoid(float x) { return __builtin_amdgcn_rcpf(1.f + __builtin_amdgcn_exp2f(-x * 1.4426950408889634f)); }
#define VM_WAIT() asm volatile("s_waitcnt vmcnt(0)" ::: "memory")
#define LDS_WAIT() asm volatile("s_waitcnt lgkmcnt(0)" ::: "memory")

#define XB_TMO      128
#define XB_XCNT(j)  (256  + 64 * (j))
#define XB_XSUB(j)  (1280 + 64 * (j))
#define XB_XGEN(j)  (2304 + 64 * (j))
#define XB_TOP      3328
#define XB_TOPGEN   3392
#define XCD_BAR_WORDS 3456
#define XB_SPIN_CAP (1u << 18)
__device__ __forceinline__ unsigned xb_ld(unsigned* p)              { return __hip_atomic_load(p, __ATOMIC_RELAXED, __HIP_MEMORY_SCOPE_AGENT); }
__device__ __forceinline__ unsigned xb_add(unsigned* p, unsigned v) { return __hip_atomic_fetch_add(p, v, __ATOMIC_RELAXED, __HIP_MEMORY_SCOPE_AGENT); }
__device__ __forceinline__ unsigned xb_xcc_id() { return (unsigned)__builtin_amdgcn_s_getreg((3 << 11) | 20) & 0xFu; }
#define XB_SPIN(cond, bar) do { unsigned _sp = 0; while (cond) { __builtin_amdgcn_s_sleep(1); \
    if ((++_sp & 255u) == 0u) { if (xb_ld(&(bar)[XB_TMO])) break; if (_sp > XB_SPIN_CAP) { atomicAdd(&(bar)[XB_TMO], 1u); break; } } } } while (0)
struct XcdBarrier { unsigned* bar; unsigned x; volatile LAS unsigned* st; };
__device__ __forceinline__ XcdBarrier xcd_barrier_post(unsigned* bar, volatile LAS unsigned* st) {
    XcdBarrier b; b.bar = bar; b.x = xb_xcc_id(); b.st = st;
    if (threadIdx.x == 0) (void)xb_add(&bar[XB_XCNT(b.x)], 1u);
    return b;
}
__device__ __forceinline__ void xcd_barrier_complete(unsigned* bar, unsigned x, unsigned& nloc, unsigned& nx) {
    const unsigned G = gridDim.x * gridDim.y * gridDim.z;
    unsigned sum, cnt, mine, sp = 0u;
    for (;;) {
        sum = 0u; cnt = 0u; mine = 0u;
#pragma unroll
        for (unsigned j = 0; j < 16; ++j) { const unsigned c = xb_ld(&bar[XB_XCNT(j)]); sum += c; cnt += (c > 0u) ? 1u : 0u; mine = (j == x) ? c : mine; }
        if (sum == G) break;
        __builtin_amdgcn_s_sleep(1);
        if ((++sp & 255u) == 0u) { if (xb_ld(&bar[XB_TMO])) break; if (sp > XB_SPIN_CAP) { atomicAdd(&bar[XB_TMO], 1u); break; } }
    }
    nloc = mine > 0u ? mine : 1u; nx = cnt > 0u ? cnt : 1u;
}
__device__ __forceinline__ void xcd_barrier(const XcdBarrier& b) {
    asm volatile("s_waitcnt vmcnt(0)" ::: "memory");
    __syncthreads();
    if (threadIdx.x == 0) {
        unsigned* bar = b.bar;
        __builtin_amdgcn_s_waitcnt(0);
        unsigned nloc = b.st[0], nx = b.st[1];
        if (nloc == 0u) { xcd_barrier_complete(bar, b.x, nloc, nx); b.st[0] = nloc; b.st[1] = nx; }
        const unsigned old = xb_add(&bar[XB_XSUB(b.x)], 1u);
        const unsigned gen = old / nloc;
        if (old + 1u == (gen + 1u) * nloc) {
            __builtin_amdgcn_fence(__ATOMIC_RELEASE, "agent");
            asm volatile("s_waitcnt vmcnt(0)" ::: "memory");
            const unsigned og = xb_add(&bar[XB_TOP], 1u);
            const unsigned tg = og / nx;
            if (og + 1u == (tg + 1u) * nx) xb_add(&bar[XB_TOPGEN], 1u);
            else XB_SPIN(xb_ld(&bar[XB_TOPGEN]) == tg, bar);
            __builtin_amdgcn_fence(__ATOMIC_ACQUIRE, "agent");
            xb_add(&bar[XB_XGEN(b.x)], 1u);
            asm volatile("s_waitcnt vmcnt(0)" ::: "memory");
        } else {
            XB_SPIN(xb_ld(&bar[XB_XGEN(b.x)]) == gen, bar);
            __builtin_amdgcn_fence(__ATOMIC_ACQUIRE, "agent");
            asm volatile("s_waitcnt vmcnt(0)" ::: "memory");
        }
    }
    __syncthreads();
}

namespace pg8 {
constexpr int BM = 256, BK = 64, HALF = 128, HTB = HALF * BK * 2, STAGE_BYTES = 8 * HTB, NXCD = 8, WGM = 8;
constexpr int GK = 2048, S_ROWS = 8192;
__host__ __device__ __forceinline__ int lds_byte(int r, int c) { const int st = (r >> 4) * 2 + (c >> 5), rr = r & 15, cc = c & 31, ob = rr * 64 + cc * 2; return st * 1024 + (ob ^ (((ob >> 9) & 1) << 5)); }
__host__ __device__ __forceinline__ void stage_rc(int b, int& R, int& C) { const int st = b / 1024, sb = b % 1024, swz = sb ^ (((sb >> 9) & 1) << 5); R = (st >> 1) * 16 + swz / 64; C = (st & 1) * 32 + (swz % 64) / 2; }
__host__ __device__ __forceinline__ int perm32(int rho) { const int n = rho >> 4, i = rho & 15; return 8 * (i >> 2) + 4 * n + (i & 3); }

struct Unit { const char* A; const char* B; const int* tok; int pm, pn, e; int half; };
constexpr size_t TSTEP = (size_t)BM * GK * 2;

struct DenseOrder {
    int nM, nN, nwg, G, c; const char* A; const char* Bt; static constexpr unsigned maxrow = 1u;
    __device__ void init(int M, int N, int G_, int c_, const void* A_, const void* Bt_) { nM = M / BM; nN = N / BM; nwg = nM * nN; G = G_; c = c_; A = (const char*)A_; Bt = (const char*)Bt_; }
    unsigned* q;
    __device__ __forceinline__ bool decode(int L, Unit& u) const {
        if (L >= nwg) return false;
        int wgid = L; { const int q = nwg / NXCD, r = nwg % NXCD, xcd = wgid % NXCD, off = wgid / NXCD; wgid = (xcd < r ? xcd * (q + 1) : r * (q + 1) + (xcd - r) * q) + off; }
        const int nig = WGM * nN, gid = wgid / nig, fm = gid * WGM, gsz = (nM - fm) < WGM ? (nM - fm) : WGM;
        u.pm = fm + ((wgid % nig) % gsz); u.pn = (wgid % nig) / gsz; u.e = 0;
        u.A = A + (size_t)u.pm * TSTEP; u.B = Bt + (size_t)u.pn * TSTEP; u.tok = nullptr; return true;
    }
};
struct MoeOrder {
    const volatile LAS int* pfx; int npn, G, c; const char* A; const char* Bt; size_t a_es, b_es; size_t ts  ; const int* toklist; unsigned maxrow  ;
    unsigned* q;
    __device__ __forceinline__ bool decode(int L, Unit& u) const {
        const int total = pfx[NE] * npn; if (L >= total) return false;
        const int gm = L / npn, pn = L - gm * npn;
        int e = 0;
#pragma unroll
        for (int s = 16; s >= 1; s >>= 1) { if (pfx[e + s] <= gm) e += s; }
        e = __builtin_amdgcn_readfirstlane(e);
        const int mt = __builtin_amdgcn_readfirstlane(gm - pfx[e]);
        u.pm = mt; u.pn = pn; u.e = e; u.half = __builtin_amdgcn_readfirstlane((pfx[40 + e] - mt * BM) <= HALF ? 1 : 0);
        u.A = toklist ? A : A + (size_t)e * a_es + (size_t)mt * ts; u.B = Bt + (size_t)e * b_es + (size_t)pn * ts; u.tok = toklist ? toklist + (size_t)e * ECAP + mt * BM : nullptr; return true;
    }
};

typedef int v8i __attribute__((ext_vector_type(8)));
template <class Epi, class Sched, bool GATHER = false, bool FP8 = false>
__device__ __forceinline__ void gemm_phase(LAS unsigned char* lds, const Sched& S, const Epi& E, LAS int* tokl) {
    const int tid = threadIdx.x, wid = __builtin_amdgcn_readfirstlane(tid >> 6), lane = tid & 63, wr = wid >> 2, wc = wid & 3, fr = lane & 15, fq = lane >> 4;
    constexpr int K = FP8 ? GK / 2 : GK, nt = K / BK;
    unsigned vc[2][2], voffB[2];
#pragma unroll
    for (int i = 0; i < 2; ++i) { int R, C; stage_rc(tid * 16 + i * 8192, R, C); const int Rb = Epi::PERM ? ((R & ~31) + perm32(R & 31)) : R;
        voffB[i] = (unsigned)(Rb * K + C) * 2u;
#pragma unroll
        for (int h = 0; h < 2; ++h) vc[h][i] = (unsigned)((R + HALF * h) * K + C) * 2u; }
#define PG8_GATHER_OFFS(TOKPTR) do { int _tz = threadIdx.x; asm volatile("" : "+v"(_tz)); _Pragma("unroll") for (int _i = 0; _i < 2; ++_i) { int _R, _C; stage_rc(_tz * 16 + _i * 8192, _R, _C); \
        _Pragma("unroll") for (int _h = 0; _h < 2; ++_h) { unsigned _tk = (unsigned)(TOKPTR)[_R + HALF * _h]; _tk = _tk < S.maxrow ? _tk : S.maxrow - 1u; vc[_h][_i] = (_tk * K + (unsigned)_C) * 2u; } } } while (0)
    constexpr size_t kstep = (size_t)(BK * 2);
    constexpr size_t hstep = (size_t)HALF * K * 2;
    const unsigned ldsw = (unsigned)wid * 1024u;
    const int aoff = lds_byte(wr * 64 + fr, fq * 8), boff = lds_byte(wc * 32 + fr, fq * 8);
#define PG8_SA(b, h) (((b) * 2 + (h)) * HTB)
#define PG8_SB(b, h) ((4 + (b) * 2 + (h)) * HTB)
#define PG8_STAGE(bufoff, gbase, voff) do { _Pragma("unroll") for (int _i = 0; _i < 2; ++_i) \
        __builtin_amdgcn_global_load_lds((const unsigned*)((const char*)(gbase) + (voff)[_i]), (LAS unsigned*)(lds + (bufoff) + ldsw + _i * 8192), 16, 0, 0); } while (0)
#define PG8_LDA(dst, b, h) do { _Pragma("unroll") for (int m = 0; m < 4; ++m) _Pragma("unroll") for (int k = 0; k < 2; ++k) dst[m][k] = *(const LAS bf16x8*)(lds + PG8_SA(b, h) + aoff + m * 2048 + k * 1024); } while (0)
#define PG8_LDB(dst, b, h) do { _Pragma("unroll") for (int n = 0; n < 2; ++n) _Pragma("unroll") for (int k = 0; k < 2; ++k) dst[n][k] = *(const LAS bf16x8*)(lds + PG8_SB(b, h) + boff + n * 2048 + k * 1024); } while (0)
struct Frag2 { bf16x8 a, b; };
#define PG8_CAT(x) (Frag2{x[0], x[1]})
#define PG8_MMA(ai, bj, At, Bt) do { __builtin_amdgcn_s_setprio(1); _Pragma("unroll") for (int m = 0; m < 4; ++m) _Pragma("unroll") for (int n = 0; n < 2; ++n) { \
        if constexpr (FP8) acc[ai][bj][m][n] = __builtin_amdgcn_mfma_scale_f32_16x16x128_f8f6f4(__builtin_bit_cast(v8i, PG8_CAT(Bt[n])), __builtin_bit_cast(v8i, PG8_CAT(At[m])), acc[ai][bj][m][n], 0, 0, 0, 0x7f7f7f7f, 0, 0x7f7f7f7f); \
        else { _Pragma("unroll") for (int k = 0; k < 2; ++k) acc[ai][bj][m][n] = __builtin_amdgcn_mfma_f32_16x16x32_bf16(Bt[n][k], At[m][k], acc[ai][bj][m][n], 0, 0, 0); } } \
        __builtin_amdgcn_s_setprio(0); } while (0)
#define PG8_WAIT_V(n) asm volatile("s_waitcnt vmcnt(" #n ")" ::: "memory")
#define PG8_WAIT_L(n) asm volatile("s_waitcnt lgkmcnt(" #n ")" ::: "memory")
#define PG8_BAR __builtin_amdgcn_s_barrier()
#define PG8_SCHED __builtin_amdgcn_sched_barrier(0)
    const int label = blockIdx.x & 7; unsigned* qp = S.q + label * 64; const bool dyn = S.q != nullptr;
    volatile LAS int* qs = (volatile LAS int*)(tokl + 2 * BM);
    int jnxt;
    if (dyn) { if (tid == 0) qs[0] = (int)xb_add(qp, 2u); __syncthreads(); jnxt = qs[0] + 1; }
    else jnxt = (int)(blockIdx.x >> 3) + 1;
    Unit cur, nxt; int ui = 0;
    if (!S.decode((jnxt - 1) * 8 + label, cur)) return;
    if (!dyn) jnxt += 31;
    f32x4 acc[2][2][4][2];
#pragma unroll
    for (int a = 0; a < 2; ++a)
#pragma unroll
        for (int b = 0; b < 2; ++b)
#pragma unroll
            for (int m = 0; m < 4; ++m)
#pragma unroll
                for (int n = 0; n < 2; ++n) acc[a][b][m][n] = (f32x4){0.f, 0.f, 0.f, 0.f};
    bf16x8 At[4][2], B0[2][2], B1[2][2];
    const char* cA = cur.A; const char* cB = cur.B;
    if constexpr (GATHER) PG8_GATHER_OFFS(cur.tok);
    PG8_STAGE(PG8_SB(0, 0), cB, voffB); PG8_STAGE(PG8_SB(0, 1), cB + hstep, voffB); PG8_STAGE(PG8_SA(0, 0), cA, vc[0]); PG8_STAGE(PG8_SA(0, 1), cA, vc[1]);
    if (wr == 1) PG8_BAR;
    PG8_WAIT_V(2); PG8_BAR;
    PG8_STAGE(PG8_SB(1, 0), cB + kstep, voffB); PG8_STAGE(PG8_SA(1, 0), cA + kstep, vc[0]); PG8_STAGE(PG8_SB(1, 1), cB + hstep + kstep, voffB);
    PG8_WAIT_V(6); PG8_BAR;
    for (;;) {
        const bool has_next = S.decode(jnxt * 8 + label, nxt);
        unsigned jreq = 0u;
        if (dyn && tid == 0) jreq = xb_add(qp, 1u);
        const char* nA = has_next ? nxt.A : cA; const char* nB = has_next ? nxt.B : cB;
        if constexpr (GATHER) {
            if (has_next && wid == 0) __builtin_amdgcn_global_load_lds((const unsigned*)(nxt.tok + lane * 4), (LAS unsigned*)(tokl + ((ui + 1) & 1) * BM), 16, 0, 0);
        }
        if (GATHER && FP8 && cur.half != 0) {
            for (int t = 0; t < nt; t += 2) {
                const bool last = (t == nt - 2);
                const char* a1 = cA + (size_t)(t + 1) * kstep;
                const char* a2 = last ? nA : cA + (size_t)(t + 2) * kstep; const char* b2 = last ? nB : cB + (size_t)(t + 2) * kstep;
                const char* a3 = a2 + kstep; const char* b3 = b2 + kstep;
                PG8_LDB(B0, 0, 0); PG8_LDB(B1, 0, 1); PG8_SCHED; PG8_LDA(At, 0, 0); PG8_STAGE(PG8_SA(1, 1), a1, vc[1]);
                if constexpr (GATHER) { if (last && has_next) PG8_GATHER_OFFS(tokl + ((ui + 1) & 1) * BM); }
                if (dyn && last && tid == 0) { asm volatile("" : "+v"(jreq)); qs[1 + (ui & 1)] = (int)jreq; }
                PG8_WAIT_V(8); PG8_WAIT_L(0); PG8_BAR; PG8_MMA(0, 0, At, B0); PG8_MMA(0, 1, At, B1); PG8_BAR; PG8_SCHED;
                PG8_STAGE(PG8_SB(0, 0), b2, voffB); PG8_STAGE(PG8_SB(0, 1), b2 + hstep, voffB); PG8_STAGE(PG8_SA(0, 0), a2, vc[0]);
                PG8_WAIT_V(8); PG8_WAIT_L(0); PG8_BAR; asm volatile("s_nop 7\n\ts_nop 7" ::: "memory"); PG8_BAR; PG8_SCHED;
                PG8_LDB(B0, 1, 0); PG8_LDB(B1, 1, 1); PG8_SCHED; PG8_LDA(At, 1, 0); PG8_STAGE(PG8_SA(0, 1), a2, vc[1]);
                PG8_WAIT_V(8); PG8_WAIT_L(0); PG8_BAR; PG8_MMA(0, 0, At, B0); PG8_MMA(0, 1, At, B1); PG8_BAR; PG8_SCHED;
                PG8_STAGE(PG8_SB(1, 0), b3, voffB); PG8_STAGE(PG8_SB(1, 1), b3 + hstep, voffB); PG8_STAGE(PG8_SA(1, 0), a3, vc[0]);
                PG8_WAIT_V(8); PG8_WAIT_L(0); PG8_BAR; asm volatile("s_nop 7\n\ts_nop 7" ::: "memory"); PG8_BAR; PG8_SCHED;
            }
        } else {
            for (int t = 0; t < nt; t += 2) {
                const bool last = (t == nt - 2);
                const char* a1 = cA + (size_t)(t + 1) * kstep;
                const char* a2 = last ? nA : cA + (size_t)(t + 2) * kstep; const char* b2 = last ? nB : cB + (size_t)(t + 2) * kstep;
                const char* a3 = a2 + kstep; const char* b3 = b2 + kstep;
                PG8_LDB(B0, 0, 0); PG8_LDB(B1, 0, 1); PG8_SCHED; PG8_LDA(At, 0, 0); PG8_STAGE(PG8_SA(1, 1), a1, vc[1]);
                if constexpr (GATHER) { if (last && has_next) PG8_GATHER_OFFS(tokl + ((ui + 1) & 1) * BM); }
                if (dyn && last && tid == 0) { asm volatile("" : "+v"(jreq)); qs[1 + (ui & 1)] = (int)jreq; }
                PG8_WAIT_V(8); PG8_WAIT_L(0); PG8_BAR; PG8_MMA(0, 0, At, B0); PG8_MMA(0, 1, At, B1); PG8_BAR; PG8_SCHED;
                PG8_LDA(At, 0, 1); PG8_STAGE(PG8_SB(0, 0), b2, voffB); PG8_STAGE(PG8_SB(0, 1), b2 + hstep, voffB); PG8_STAGE(PG8_SA(0, 0), a2, vc[0]);
                PG8_WAIT_V(8); PG8_WAIT_L(0); PG8_BAR; PG8_MMA(1, 0, At, B0); PG8_MMA(1, 1, At, B1); PG8_BAR; PG8_SCHED;
                PG8_LDB(B0, 1, 0); PG8_LDB(B1, 1, 1); PG8_SCHED; PG8_LDA(At, 1, 0); PG8_STAGE(PG8_SA(0, 1), a2, vc[1]);
                PG8_WAIT_V(8); PG8_WAIT_L(0); PG8_BAR; PG8_MMA(0, 0, At, B0); PG8_MMA(0, 1, At, B1); PG8_BAR; PG8_SCHED;
                PG8_LDA(At, 1, 1); PG8_STAGE(PG8_SB(1, 0), b3, voffB); PG8_STAGE(PG8_SB(1, 1), b3 + hstep, voffB); PG8_STAGE(PG8_SA(1, 0), a3, vc[0]);
                PG8_WAIT_V(8); PG8_WAIT_L(0); PG8_BAR; PG8_MMA(1, 0, At, B0); PG8_MMA(1, 1, At, B1); PG8_BAR; PG8_SCHED;
            }
        }
        if (wr == 0) PG8_BAR;
        { int tz = threadIdx.x; asm volatile("" : "+v"(tz)); const int lz = tz & 63; E(acc, cur, wr, wc, lz & 15, lz >> 4); }
        if (!has_next) break;
#pragma unroll
        for (int a = 0; a < 2; ++a)
#pragma unroll
            for (int b = 0; b < 2; ++b)
#pragma unroll
                for (int m = 0; m < 4; ++m)
#pragma unroll
                    for (int n = 0; n < 2; ++n) acc[a][b][m][n] = (f32x4){0.f, 0.f, 0.f, 0.f};
        jnxt = dyn ? qs[1 + (ui & 1)] : jnxt + 32;
        cur = nxt; cA = nA; cB = nB; ++ui;
        if (wr == 1) PG8_BAR;
    }
    PG8_WAIT_V(0);
    PG8_BAR;
#undef PG8_SA
#undef PG8_SB
#undef PG8_STAGE
#undef PG8_LDA
#undef PG8_LDB
#undef PG8_MMA
#undef PG8_CAT
#undef PG8_GATHER_OFFS
#undef PG8_WAIT_V
#undef PG8_WAIT_L
#undef PG8_BAR
#undef PG8_SCHED
}

struct EpiInProj {
    static constexpr bool PERM = true;
    bf16_t *Q, *U; float* ksum;
    __device__ __forceinline__ void operator()(const f32x4 (&acc)[2][2][4][2], const Unit& u, int wr, int wc, int fr, int fq) const {
        const int row0 = u.pm * BM + wr * 64 + fr;
        if (u.pn < 12) {
            const int t = u.pn >> 2; bf16_t* base = Q + (size_t)t * ((WS_KB - WS_QB) / 2);
            const int col0 = (u.pn & 3) * 256 + wc * 32 + 8 * fq;
#pragma unroll
            for (int ai = 0; ai < 2; ++ai)
#pragma unroll
                for (int m = 0; m < 4; ++m) { bf16_t* rowp = base + (size_t)(row0 + ai * HALF + m * 16) * DA + col0;
#pragma unroll
                    for (int bj = 0; bj < 2; ++bj) { const f32x4 v0 = acc[ai][bj][m][0], v1 = acc[ai][bj][m][1];
                        u32x4 w; w.x = cvt_pk_bf16(v0[0], v0[1]); w.y = cvt_pk_bf16(v0[2], v0[3]); w.z = cvt_pk_bf16(v1[0], v1[1]); w.w = cvt_pk_bf16(v1[2], v1[3]);
                        *(u32x4*)(rowp + bj * HALF) = w; } }
            if (t == 1) {
#pragma unroll
                for (int bj = 0; bj < 2; ++bj)
#pragma unroll
                    for (int n = 0; n < 2; ++n) { f32x4 s = (f32x4){0.f, 0.f, 0.f, 0.f};
#pragma unroll
                        for (int ai = 0; ai < 2; ++ai)
#pragma unroll
                            for (int m = 0; m < 4; ++m) s += acc[ai][bj][m][n];
#pragma unroll
                        for (int e = 0; e < 4; ++e) { float v = s[e]; v += __shfl_xor(v, 1); v += __shfl_xor(v, 2); v += __shfl_xor(v, 4); v += __shfl_xor(v, 8);
                            if (fr == 0) atomicAdd(ksum + (size_t)u.pm * DA + col0 + bj * HALF + 4 * n + e, v); } }
            }
        } else {
            const int ch0 = (u.pn - 12) * 128 + wc * 32 + 8 * fq;
#pragma unroll
            for (int ai = 0; ai < 2; ++ai)
#pragma unroll
                for (int m = 0; m < 4; ++m) { bf16_t* rowp = U + (size_t)(row0 + ai * HALF + m * 16) * DC + ch0;
                    float o[8];
#pragma unroll
                    for (int n = 0; n < 2; ++n)
#pragma unroll
                        for (int e = 0; e < 4; ++e) o[n * 4 + e] = acc[ai][0][m][n][e] * fast_sigmoid(acc[ai][1][m][n][e]);
                    u32x4 w; w.x = cvt_pk_bf16(o[0], o[1]); w.y = cvt_pk_bf16(o[2], o[3]); w.z = cvt_pk_bf16(o[4], o[5]); w.w = cvt_pk_bf16(o[6], o[7]);
                    *(u32x4*)rowp = w; }
        }
    }
};
struct EpiOutProj {
    static constexpr bool PERM = true;
    const float* X; bf16_t* H;
    __device__ __forceinline__ void operator()(const f32x4 (&acc)[2][2][4][2], const Unit& u, int wr, int wc, int fr, int fq) const {
        const int row0 = u.pm * BM + wr * 64 + fr, col0 = u.pn * BM + wc * 32 + 8 * fq;
#pragma unroll
        for (int ai = 0; ai < 2; ++ai)
#pragma unroll
            for (int m = 0; m < 4; ++m) { const size_t off = (size_t)(row0 + ai * HALF + m * 16) * DM + col0;
#pragma unroll
                for (int bj = 0; bj < 2; ++bj) { const f32x4 x0 = *(const f32x4*)(X + off + bj * HALF), x1 = *(const f32x4*)(X + off + bj * HALF + 4);
                    const f32x4 v0 = x0 * DN_ALPHA + acc[ai][bj][m][0], v1 = x1 * DN_ALPHA + acc[ai][bj][m][1];
                    u32x4 w; w.x = cvt_pk_bf16(v0[0], v0[1]); w.y = cvt_pk_bf16(v0[2], v0[3]); w.z = cvt_pk_bf16(v1[0], v1[1]); w.w = cvt_pk_bf16(v1[2], v1[3]);
                    *(u32x4*)(H + off + bj * HALF) = w; } }
    }
};
struct EpiGateUp {
    static constexpr bool PERM = true;
    unsigned char* ACT; const float* bias;
    __device__ __forceinline__ void operator()(const f32x4 (&acc)[2][2][4][2], const Unit& u, int wr, int wc, int fr, int fq) const {
        const int row0 = u.pm * BM + wr * 64 + fr, ch0 = u.pn * 128 + wc * 32 + 8 * fq;
        const float* bg = bias + (size_t)u.e * 4096 + ch0;
        f32x4 bgv[2], buv[2];
#pragma unroll
        for (int n = 0; n < 2; ++n) { bgv[n] = *(const f32x4*)(bg + 4 * n); buv[n] = *(const f32x4*)(bg + 2048 + 4 * n); }
        unsigned char* base = ACT + (size_t)u.e * ECAP * DFF;
        constexpr float inv = 1.f / (SC_H * SC_W);
#pragma unroll
        for (int ai = 0; ai < 2; ++ai)
#pragma unroll
            for (int m = 0; m < 4; ++m) { unsigned char* rowp = base + (size_t)(row0 + ai * HALF + m * 16) * DFF + ch0;
                float o[8];
#pragma unroll
                for (int n = 0; n < 2; ++n)
#pragma unroll
                    for (int e = 0; e < 4; ++e) { float g = acc[ai][0][m][n][e] * inv + bgv[n][e], uu = acc[ai][1][m][n][e] * inv + buv[n][e];
                        g = fminf(g, 7.f); uu = fminf(fmaxf(uu, -7.f), 7.f);
                        o[n * 4 + e] = (uu + 1.f) * (g * fast_sigmoid(1.702f * g)) * SC_ACT; }
                u32x2 w; w.x = cvt4_fp8(o[0], o[1], o[2], o[3]); w.y = cvt4_fp8(o[4], o[5], o[6], o[7]);
                *(u32x2*)rowp = w; }
    }
};
struct EpiDown {
    static constexpr bool PERM = true;
    unsigned char* Y; const float* bias; const float* gate;
    __device__ __forceinline__ void operator()(const f32x4 (&acc)[2][2][4][2], const Unit& u, int wr, int wc, int fr, int fq) const {
        const int row0 = u.pm * BM + wr * 64 + fr, col0 = u.pn * BM + wc * 32 + 8 * fq;
        const float* bb = bias + (size_t)u.e * DM + col0;
        unsigned char* base = Y + (size_t)u.e * ECAP * DM; const float* gp = gate + (size_t)u.e * ECAP;
        constexpr float inv = 1.f / (SC_ACT * SC_W);
#pragma unroll
        for (int bj = 0; bj < 2; ++bj) { const f32x4 b0 = *(const f32x4*)(bb + bj * HALF), b1 = *(const f32x4*)(bb + bj * HALF + 4);
#pragma unroll
            for (int ai = 0; ai < 2; ++ai)
#pragma unroll
                for (int m = 0; m < 4; ++m) { const int row = row0 + ai * HALF + m * 16; const float gt = gp[row] * SC_Y;
                    const f32x4 v0 = (acc[ai][bj][m][0] * inv + b0) * gt, v1 = (acc[ai][bj][m][1] * inv + b1) * gt;
                    u32x2 w; w.x = cvt4_fp8(v0[0], v0[1], v0[2], v0[3]); w.y = cvt4_fp8(v1[0], v1[1], v1[2], v1[3]);
                    *(u32x2*)(base + (size_t)row * DM + col0 + bj * HALF) = w; }
            asm volatile("" ::: "memory"); }
    }
};
}

struct Args { const float* in[17]; float* out; unsigned char* ws; int ph_lo, ph_hi; };
enum { I_X = 0, I_WIN, I_CONVW, I_CONVB, I_CLNG, I_CLNB, I_WOUT, I_LN1G, I_LN1B, I_WR, I_BR, I_WGU, I_BGU, I_WD, I_BD, I_LN2G, I_LN2B };

__device__ __forceinline__ int rowmap(int mode, int n) {
    if (mode == 1) {
        if (n < 3072) return n;
        if (n < 4096) { const int c = n - 3072; return 3072 + (c >> 7) * 256 + (c & 127); }
        const int c = n - 4096; return 3072 + (c >> 7) * 256 + 128 + (c & 127);
    }
    if (mode == 2) {
        if (n < 2048) return (n >> 7) * 256 + (n & 127);
        const int c = n - 2048; return (c >> 7) * 256 + 128 + (c & 127);
    }
    return n;
}
struct TItem { const float* src; bf16_t* dst; int N, mode, k0, n0; };
constexpr int TI_WIN = 32 * 20, TI_WOUT = 32 * 8, TI_GU = 32 * 32 * 16, TI_D = 32 * 32 * 8, TI_ALL = TI_WIN + TI_WOUT + TI_GU + TI_D;
__device__ __forceinline__ TItem t_decode(const Args& a, int it) {
    TItem r;
    if (it < TI_WIN) { r.src = a.in[I_WIN]; r.dst = (bf16_t*)(a.ws + WS_WINT); r.N = INCOLS; r.mode = 1; r.k0 = (it / 20) * 64; r.n0 = (it % 20) * 256; return r; }
    it -= TI_WIN;
    if (it < TI_WOUT) { r.src = a.in[I_WOUT]; r.dst = (bf16_t*)(a.ws + WS_WOUTT); r.N = DM; r.mode = 0; r.k0 = (it / 8) * 64; r.n0 = (it % 8) * 256; return r; }
    it -= TI_WOUT;
    if (it < TI_GU) { const int e = it / 512, j = it % 512; r.src = a.in[I_WGU] + (size_t)e * 2048 * 4096; r.dst = (bf16_t*)(a.ws + WS_WGUT + (size_t)e * 4096 * 2048); r.N = 4096; r.mode = 2; r.k0 = (j / 32) * 128; r.n0 = (j % 32) * 128; return r; }
    it -= TI_GU;
    { const int e = it / 256, j = it % 256; r.src = a.in[I_WD] + (size_t)e * 2048 * 2048; r.dst = (bf16_t*)(a.ws + WS_WDT + (size_t)e * 2048 * 2048); r.N = 2048; r.mode = 0; r.k0 = (j / 16) * 128; r.n0 = (j % 16) * 128; return r; }
}
__device__ __forceinline__ void t_load(const TItem& it, f32x4 (&v)[8], int tid) {
    const int kq = tid >> 6, nl = tid & 63;
    const float* p = it.src + (size_t)(it.k0 + kq * 8) * it.N + it.n0 + 4 * nl;
#pragma unroll
    for (int i = 0; i < 8; ++i) v[i] = *(const f32x4*)(p + (size_t)i * it.N);
}
__device__ __forceinline__ void t_process(const TItem& it, const f32x4 (&v)[8], LAS unsigned char* scr, int tid) {
    const int kq = tid >> 6, nl = tid & 63;
#pragma unroll
    for (int j = 0; j < 4; ++j) { u32x4 w; w.x = cvt_pk_bf16(v[0][j], v[1][j]); w.y = cvt_pk_bf16(v[2][j], v[3][j]); w.z = cvt_pk_bf16(v[4][j], v[5][j]); w.w = cvt_pk_bf16(v[6][j], v[7][j]);
        *(LAS u32x4*)(scr + (4 * nl + j) * 128 + ((kq ^ (nl & 7)) * 16)) = w; }
    __syncthreads();
#pragma unroll
    for (int p = 0; p < 4; ++p) { const int r = tid + 512 * p, nn = r >> 3, ch = r & 7;
        const u32x4 w = *(const LAS u32x4*)(scr + nn * 128 + ((ch ^ ((nn >> 2) & 7)) * 16));
        const int row = rowmap(it.mode, it.n0 + nn);
        *(u32x4*)(it.dst + (size_t)row * 2048 + it.k0 + ch * 8) = w; }
    __syncthreads();
}
__device__ __forceinline__ void t8_load(const TItem& it, f32x4 (&v)[8], int tid) {
    const int kq = tid >> 5, nl = tid & 31;
    const float* p = it.src + (size_t)(it.k0 + kq * 8) * it.N + it.n0 + 4 * nl;
#pragma unroll
    for (int i = 0; i < 8; ++i) v[i] = __builtin_nontemporal_load((const f32x4*)(p + (size_t)i * it.N));
}
template <bool SYNC2 = true> __device__ __forceinline__ void t8_process(const TItem& it, const f32x4 (&v)[8], LAS unsigned char* scr, int tid) {
    const int kq = tid >> 5, nl = tid & 31;
#pragma unroll
    for (int j = 0; j < 4; ++j) { u32x2 w; w.x = cvt4_fp8(v[0][j] * SC_W, v[1][j] * SC_W, v[2][j] * SC_W, v[3][j] * SC_W); w.y = cvt4_fp8(v[4][j] * SC_W, v[5][j] * SC_W, v[6][j] * SC_W, v[7][j] * SC_W);
        *(LAS u32x2*)(scr + (4 * nl + j) * 128 + (((kq >> 1) ^ (nl & 7)) * 16) + (kq & 1) * 8) = w; }
    __syncthreads();
#pragma unroll
    for (int p = 0; p < 2; ++p) { const int r = tid + 512 * p, nn = r >> 3, ch = r & 7;
        const u32x4 w = *(const LAS u32x4*)(scr + nn * 128 + ((ch ^ ((nn >> 2) & 7)) * 16));
        const int row = rowmap(it.mode, it.n0 + nn);
        __builtin_nontemporal_store(w, (u32x4*)((unsigned char*)it.dst + (size_t)row * 2048 + it.k0 + ch * 16)); }
    if (SYNC2) __syncthreads();
}
constexpr int CQ_N = 0;
constexpr int CV_P1 = 10240, CV_P1_WGS = 128, CV_P7_WGS = 96, CV_P3_WGS = 128;
__device__ __forceinline__ void phase_convert(const Args& a, LAS unsigned char* lds) {
    const int tid = threadIdx.x, G = gridDim.x, c = blockIdx.x;
    { const f32x4* src = (const f32x4*)a.in[I_X]; u32x4* dst = (u32x4*)(a.ws + WS_XB); const size_t n8 = (size_t)S * DM / 8;
      const size_t step = (size_t)G * NTHR;
      for (size_t i0 = (size_t)c * NTHR + tid; i0 < n8; i0 += 4 * step) { f32x4 p[4], q[4];
#pragma unroll
          for (int u = 0; u < 4; ++u) { const size_t i = i0 + u * step; if (i < n8) { p[u] = __builtin_nontemporal_load(src + 2 * i); q[u] = __builtin_nontemporal_load(src + 2 * i + 1); } }
#pragma unroll
          for (int u = 0; u < 4; ++u) { const size_t i = i0 + u * step; if (i < n8) {
              u32x4 w; w.x = cvt_pk_bf16(p[u][0], p[u][1]); w.y = cvt_pk_bf16(p[u][2], p[u][3]); w.z = cvt_pk_bf16(q[u][0], q[u][1]); w.w = cvt_pk_bf16(q[u][2], q[u][3]); dst[i] = w; } } } }
    { int* idl = (int*)(a.ws + WS_IDLIST); for (int i = c * NTHR + tid; i < NE * ECAP; i += G * NTHR) idl[i] = i; }
    { const float* wr = a.in[I_WR]; bf16_t* img = (bf16_t*)(a.ws + WS_WRT);
      for (int idx = c * NTHR + tid; idx < DM * NE; idx += G * NTHR) { const int j = idx & 7, l = (idx >> 3) & 63, et = (idx >> 9) & 1, ss = idx >> 10;
          const float w = wr[(size_t)(32 * ss + 8 * (l >> 4) + j) * NE + 16 * et + (l & 15)];
          const unsigned hi = cvt_pk_bf16(w, 0.f) & 0xffffu; const float wl = w - bf_lo(hi);
          img[idx] = (bf16_t)hi; img[DM * NE + idx] = (bf16_t)(cvt_pk_bf16(wl, 0.f) & 0xffffu); } }
    f32x4 va[8], vb[8];
    constexpr int TI_BF = TI_WIN + TI_WOUT;
    for (int it = c; it < TI_WIN; it += G) { const TItem ia = t_decode(a, it); t_load(ia, va, tid); t_process(ia, va, lds, tid); }
    int it = TI_BF + TI_GU + c;
    constexpr int TI_ALL0 = TI_BF + TI_GU;
    if (it < TI_ALL0) { TItem ia = t_decode(a, it); t8_load(ia, va, tid);
        for (;;) {
            const int itb = it + G; TItem ib; const bool hb = itb < TI_ALL0; if (hb) { ib = t_decode(a, itb); t8_load(ib, vb, tid); }
            t8_process(ia, va, lds, tid);
            if (!hb) break;
            const int ita = itb + G; const bool ha = ita < TI_ALL0; if (ha) { ia = t_decode(a, ita); t8_load(ia, va, tid); }
            t8_process(ib, vb, lds, tid);
            if (!ha) break;
            it = ita;
        }
    }
}
__device__ __forceinline__ void moe_convert_items(const Args& a, LAS unsigned char* lds, int first, int n) {
    constexpr int TI_BF = TI_WIN + TI_WOUT;
    const int tid = threadIdx.x;
    f32x4 va[8], vb[8], vc[8];
    const int it0 = TI_BF + first, itend = TI_BF + first + n;
    TItem ia, ib, ic;
    if (it0 < itend) { ia = t_decode(a, it0); t8_load(ia, va, tid); }
    if (it0 + 1 < itend) { ib = t_decode(a, it0 + 1); t8_load(ib, vb, tid); }
    for (int it = it0; it < itend; it += 3) {
        if (it + 2 < itend) { ic = t_decode(a, it + 2); t8_load(ic, vc, tid); }
        t8_process<false>(ia, va, lds + ((it - it0) & 1) * 16384, tid);
        if (it + 1 >= itend) break;
        if (it + 3 < itend) { ia = t_decode(a, it + 3); t8_load(ia, va, tid); }
        t8_process<false>(ib, vb, lds + ((it - it0 + 1) & 1) * 16384, tid);
        if (it + 2 >= itend) break;
        if (it + 4 < itend) { ib = t_decode(a, it + 4); t8_load(ib, vb, tid); }
        t8_process<false>(ic, vc, lds + ((it - it0) & 1) * 16384, tid);
    }
    __syncthreads();
}
__device__ __forceinline__ void moe_convert_items_deep(const Args& a, LAS unsigned char* lds, int first, int n) {
    constexpr int TI_BF = TI_WIN + TI_WOUT;
    const int tid = threadIdx.x;
    f32x4 va[8], vb[8], vc[8];
    const int it0 = TI_BF + first, itend = TI_BF + first + n;
    TItem ia, ib, ic;
    const int last = itend - 1;
    if (it0 < itend) {
        ia = t_decode(a, it0); t8_load(ia, va, tid);
        ib = t_decode(a, min(it0 + 1, last)); t8_load(ib, vb, tid);
        for (int it = it0; it < itend; it += 3) {
            ic = t_decode(a, min(it + 2, last)); t8_load(ic, vc, tid);
            t8_process<false>(ia, va, lds + ((it - it0) & 1) * 16384, tid);
            if (it + 1 >= itend) break;
            ia = t_decode(a, min(it + 3, last)); t8_load(ia, va, tid);
            t8_process<false>(ib, vb, lds + ((it - it0 + 1) & 1) * 16384, tid);
            if (it + 2 >= itend) break;
            ib = t_decode(a, min(it + 4, last)); t8_load(ib, vb, tid);
            t8_process<false>(ic, vc, lds + ((it - it0) & 1) * 16384, tid);
        }
    }
    __syncthreads();
}
constexpr int CQ_CHUNK = 2, TI_MOE = TI_GU + TI_D;
__device__ __forceinline__ void cq_drain(const Args& a, LAS unsigned char* lds, volatile LAS int* bc, int limit) {
    unsigned* cq = (unsigned*)(a.ws + WS_CTL) + CW_CQ;
    for (;;) {
        if (threadIdx.x == 0) { int q = -1; if ((int)xb_ld(cq) < limit) { q = (int)xb_add(cq, CQ_CHUNK); if (q >= limit) q = -1; } bc[0] = q; }
        __syncthreads(); const int q = bc[0]; __syncthreads();
        if (q < 0) break;
        moe_convert_items(a, lds, q, CQ_CHUNK);
    }
}
__device__ __forceinline__ void cq_while_waiting(const Args& a, LAS unsigned char* lds, volatile LAS int* bc, unsigned target, int limit) {
    unsigned* cq = (unsigned*)(a.ws + WS_CTL) + CW_CQ; unsigned* ready = (unsigned*)(a.ws + WS_CTL) + CW_READY;
    __syncthreads();
    if (threadIdx.x == 0) (void)xb_add(ready, 1u);
    for (;;) {
        if (threadIdx.x == 0) { int q = -1; if (xb_ld(ready) + 2u < target && (int)xb_ld(cq) < limit) { q = (int)xb_add(cq, CQ_CHUNK); if (q >= limit) q = -1; } bc[0] = q; }
        __syncthreads(); const int q = bc[0]; __syncthreads();
        if (q < 0) break;
        moe_convert_items(a, lds, q, CQ_CHUNK);
    }
}

__device__ __forceinline__ void phase_gate_conv(const Args& a, LAS unsigned char* lds, bool dry) {
    const int tid = threadIdx.x, wid = __builtin_amdgcn_readfirstlane(tid >> 6), lane = tid & 63;
    const bf16_t* QB = (const bf16_t*)(a.ws + WS_QB);
    const float* ksum = (const float*)(a.ws + WS_CTL + CTL_KSUM);
    unsigned* acnt = (unsigned*)(a.ws + WS_CTL) + (dry ? CW_ACNT2 : CW_ACNT);
    int* alist = (int*)(a.ws + (dry ? WS_ACT : WS_ALIST));
    float* LSE = (float*)(a.ws + (dry ? WS_ACT + 16 * MiB : WS_LSE));
    LAS int* lcnt = (LAS int*)(lds + MISC_OFF + 4096);
    LAS int* lbase = lcnt + 256;
    LAS int* selb = lbase + 256;
    for (int chunk = blockIdx.x; chunk < S / 32; chunk += gridDim.x) {
        const int qb = chunk >> 3;
        const int h = wid;
        if (tid < 256) lcnt[tid] = 0;
        __syncthreads();
        const int r32 = lane & 31, hi = lane >> 5;
        const float* kp = ksum + (size_t)r32 * DA + h * HD + hi * 8;
        const bf16_t* qp = QB + (size_t)(chunk * 32 + r32) * DA + h * HD + hi * 8;
        f32x16 sc = {};
#pragma unroll
        for (int ss = 0; ss < 8; ++ss) {
            const f32x4 k0 = *(const f32x4*)(kp + ss * 16), k1 = *(const f32x4*)(kp + ss * 16 + 4);
            const bf16x8 qf = *(const bf16x8*)(qp + ss * 16);
            u32x4 ah, al;
            ah.x = cvt_pk_bf16(k0[0], k0[1]); ah.y = cvt_pk_bf16(k0[2], k0[3]); ah.z = cvt_pk_bf16(k1[0], k1[1]); ah.w = cvt_pk_bf16(k1[2], k1[3]);
            al.x = cvt_pk_bf16(k0[0] - bf_lo(ah.x), k0[1] - bf_hi(ah.x)); al.y = cvt_pk_bf16(k0[2] - bf_lo(ah.y), k0[3] - bf_hi(ah.y));
            al.z = cvt_pk_bf16(k1[0] - bf_lo(ah.z), k1[1] - bf_hi(ah.z)); al.w = cvt_pk_bf16(k1[2] - bf_lo(ah.w), k1[3] - bf_hi(ah.w));
            sc = __builtin_amdgcn_mfma_f32_32x32x16_bf16(__builtin_bit_cast(bf16x8, ah), qf, sc, 0, 0, 0);
            sc = __builtin_amdgcn_mfma_f32_32x32x16_bf16(__builtin_bit_cast(bf16x8, al), qf, sc, 0, 0, 0);
        }
        float v[16];
#pragma unroll
        for (int r = 0; r < 16; ++r) { const int nb = (r & 3) + 8 * (r >> 2) + 4 * hi; v[r] = nb < qb ? sc[r] : -INFINITY; }
        float tv[3]; int ti[3];
#pragma unroll
        for (int s3 = 0; s3 < 3; ++s3) { float bv = v[0]; int bi = 4 * hi;
#pragma unroll
            for (int r = 1; r < 16; ++r) { const int nb = (r & 3) + 8 * (r >> 2) + 4 * hi; if (v[r] > bv) { bv = v[r]; bi = nb; } }
            tv[s3] = bv; ti[s3] = bi;
#pragma unroll
            for (int r = 0; r < 16; ++r) { const int nb = (r & 3) + 8 * (r >> 2) + 4 * hi; if (nb == bi) v[r] = -INFINITY; } }
        float pv3[3]; int pi3[3];
#pragma unroll
        for (int s3 = 0; s3 < 3; ++s3) { pv3[s3] = __shfl_xor(tv[s3], 32); pi3[s3] = __shfl_xor(ti[s3], 32); }
        int sel[3]; { int ia = 0, ib = 0;
#pragma unroll
            for (int s3 = 0; s3 < 3; ++s3) { const float va = ia == 0 ? tv[0] : (ia == 1 ? tv[1] : tv[2]), vb = ib == 0 ? pv3[0] : (ib == 1 ? pv3[1] : pv3[2]);
                const int na = ia == 0 ? ti[0] : (ia == 1 ? ti[1] : ti[2]), nb2 = ib == 0 ? pi3[0] : (ib == 1 ? pi3[1] : pi3[2]);
                const bool ta = (va > vb) || (va == vb && na < nb2);
                const float bv = ta ? va : vb; sel[s3] = (bv == -INFINITY) ? -1 : (ta ? na : nb2);
                if (ta) ++ia; else ++ib; } }
        if (hi == 0) {
            const int t = chunk * 32 + r32, p = wid * 32 + r32;
#pragma unroll
            for (int s3 = 0; s3 < 3; ++s3) {
                if (sel[s3] >= 0) { const int rank = __hip_atomic_fetch_add(lcnt + h * NBLK + sel[s3], 1, __ATOMIC_RELAXED, __HIP_MEMORY_SCOPE_WORKGROUP); selb[p * 3 + s3] = (sel[s3] << 16) | rank; }
                else { selb[p * 3 + s3] = -1; LSE[((size_t)t * NH + h) * 4 + s3] = -INFINITY; }
            }
        }
        __syncthreads();
        if (tid < 256) { const int c = lcnt[tid]; if (c > 0) lbase[tid] = (int)atomicAdd(acnt + tid * 64, (unsigned)c); }
        __syncthreads();
        if (tid < 256) { const int hh = tid >> 5, t = chunk * 32 + (tid & 31);
#pragma unroll
            for (int s = 0; s < 3; ++s) { const int v2 = selb[tid * 3 + s]; if (v2 >= 0) { const int bk = hh * NBLK + (v2 >> 16); alist[(size_t)bk * S + lbase[bk] + (v2 & 0xffff)] = t | (s << 16); } } }
        __syncthreads();
    }
    __syncthreads();
    const bf16_t* UB = (const bf16_t*)(a.ws + WS_UB);
    bf16_t* MIX = (bf16_t*)(a.ws + WS_MIXIN);
    const float* cw = a.in[I_CONVW]; const float* cb = a.in[I_CONVB]; const float* lg = a.in[I_CLNG]; const float* lb = a.in[I_CLNB];
    LAS float* red = (LAS float*)(lds + MISC_OFF + 1024);
    const int ch = 2 * tid;
    f32x2 w[CONVW];
#pragma unroll
    for (int j = 0; j < CONVW; ++j) w[j] = *(const f32x2*)(cw + (size_t)j * DC + ch);
    const f32x2 bias = *(const f32x2*)(cb + ch);
    for (int tile = blockIdx.x; tile < S / 16; tile += gridDim.x) {
        const int t0 = tile * 16;
        f32x2 acc[16];
#pragma unroll
        for (int o = 0; o < 16; ++o) acc[o] = bias;
        unsigned uraw[46];
#pragma unroll
        for (int r = 0; r < 46; ++r) { const int t = t0 - 30 + r; uraw[r] = *(const unsigned*)(UB + (size_t)(t >= 0 ? t : 0) * DC + ch); }
        if (t0 < 30) {
#pragma unroll
            for (int r = 0; r < 30; ++r) uraw[r] = (t0 - 30 + r >= 0) ? uraw[r] : 0u;
        }
#pragma unroll
        for (int r = 0; r < 46; ++r) {
            const f32x2 u2 = (f32x2){bf_lo(uraw[r]), bf_hi(uraw[r])};
#pragma unroll
            for (int o = 0; o < 16; ++o) { const int j = r - o; if (j >= 0 && j < CONVW) acc[o] += w[j] * u2; }
        }
        float mean[16];
#define RED16(EXPR, DST) do { float rv[16]; _Pragma("unroll") for (int o = 0; o < 16; ++o) rv[o] = (EXPR); \
        _Pragma("unroll") for (int st = 0; st < 4; ++st) { const int m = 32 >> st, nv = 8 >> st; const bool up = (lane & m) != 0; \
            _Pragma("unroll") for (int v = 0; v < nv; ++v) { const float lo_ = rv[v], hi_ = rv[v + nv]; const float send = up ? lo_ : hi_; const float recv = __shfl_xor(send, m); rv[v] = (up ? hi_ : lo_) + recv; } } \
        float tot = rv[0]; tot += __shfl_xor(tot, 2); tot += __shfl_xor(tot, 1); \
        if ((lane & 3) == 0) (DST)[wid * 16 + (((lane >> 5) & 1) * 8 + ((lane >> 4) & 1) * 4 + ((lane >> 3) & 1) * 2 + ((lane >> 2) & 1))] = tot; } while (0)
        RED16(acc[o][0] + acc[o][1], red);
        __syncthreads();
#pragma unroll
        for (int o = 0; o < 16; ++o) { float s = 0.f;
#pragma unroll
            for (int w8 = 0; w8 < 8; ++w8) s += red[w8 * 16 + o];
            mean[o] = s * (1.f / DC); acc[o] -= mean[o]; }
        RED16(acc[o][0] * acc[o][0] + acc[o][1] * acc[o][1], red + 128);
#undef RED16
        __syncthreads();
        const f32x2 g2 = *(const f32x2*)(lg + ch), b2 = *(const f32x2*)(lb + ch);
#pragma unroll
        for (int o = 0; o < 16; ++o) { float s = 0.f;
#pragma unroll
            for (int w8 = 0; w8 < 8; ++w8) s += red[128 + w8 * 16 + o];
            const float rstd = 1.f / sqrtf(s * (1.f / DC) + LN_EPS);
            const f32x2 y = acc[o] * rstd * g2 + b2;
            const float o0 = y[0] * fast_sigmoid(y[0]), o1 = y[1] * fast_sigmoid(y[1]);
            *(unsigned*)(MIX + (size_t)(t0 + o) * DM + DA + ch) = cvt_pk_bf16(o0, o1); }
        __syncthreads();
    }
}

namespace att {
constexpr int QBLK = 32, KVBLK = 64;
constexpr float SCALE = 0.088388347648318440f;
constexpr int SHM_V = KVBLK * HD * 2, SHM_K = KVBLK * HD * 2;
constexpr int LDQ = DA, LDK = DA;
#define KSWZ(row, colB) ((row) * 256 + ((colB) ^ (((row) & 7) << 4)))
#define SBAR() __builtin_amdgcn_sched_barrier(0)
__device__ __forceinline__ int crow(int r, int hi) { return (r & 3) + 8 * (r >> 2) + 4 * hi; }
__device__ __forceinline__ void bias_mask(f32x16& p0, f32x16& p1, float dist0, float coef, bool MASK) {
#pragma unroll
    for (int r = 0; r < 16; ++r) { const float c = (float)((r & 3) + 8 * (r >> 2)); const float d0 = dist0 - c, d1 = dist0 - c - 32.f;
        p0[r] = fmaf(coef, d0, p0[r]); p1[r] = fmaf(coef, d1, p1[r]);
        if (MASK) { if (d0 < 0.f) p0[r] = -1e30f; if (d1 < 0.f) p1[r] = -1e30f; } }
}
__device__ __forceinline__ void partialSM(f32x16& p0, f32x16& p1, float& m_reg, float& mn, float& alpha) {
    constexpr float C = SCALE * 1.4426950408889634f;
    float pmax = p0[0];
#pragma unroll
    for (int r = 1; r < 16; ++r) pmax = fmaxf(pmax, p0[r]);
#pragma unroll
    for (int r = 0; r < 16; ++r) pmax = fmaxf(pmax, p1[r]);
    { auto rr = __builtin_amdgcn_permlane32_swap(__float_as_uint(pmax), __float_as_uint(pmax), false, false);
      pmax = fmaxf(__uint_as_float(rr[0]), __uint_as_float(rr[1])); }
    mn = fmaxf(m_reg, pmax); alpha = __builtin_amdgcn_exp2f((m_reg - mn) * C); m_reg = mn;
    const float mnC = -mn * C;
#pragma unroll
    for (int r = 0; r < 16; ++r) p0[r] = fmaf(p0[r], C, mnC);
#pragma unroll
    for (int r = 0; r < 16; ++r) p1[r] = fmaf(p1[r], C, mnC);
#pragma unroll
    for (int r = 0; r < 16; ++r) p0[r] = __builtin_amdgcn_exp2f(p0[r]);
}
__device__ __forceinline__ void finishSM(f32x16& p0, f32x16& p1, float alpha, float& l_reg, bf16x8& pa0, bf16x8& pa1, bf16x8& pa2, bf16x8& pa3) {
#pragma unroll
    for (int r = 0; r < 16; ++r) p1[r] = __builtin_amdgcn_exp2f(p1[r]);
    float ps = 0;
#pragma unroll
    for (int r = 0; r < 16; ++r) ps += p0[r];
#pragma unroll
    for (int r = 0; r < 16; ++r) ps += p1[r];
    { auto rr = __builtin_amdgcn_permlane32_swap(__float_as_uint(ps), __float_as_uint(ps), false, false);
      ps = __uint_as_float(rr[0]) + __uint_as_float(rr[1]); }
    l_reg = l_reg * alpha + ps;
#define PK4(P, BASE, OUT) do { unsigned a0 = cvt_pk_bf16(P[BASE + 0], P[BASE + 1]), a1 = cvt_pk_bf16(P[BASE + 2], P[BASE + 3]);   \
    unsigned b0 = cvt_pk_bf16(P[BASE + 4], P[BASE + 5]), b1 = cvt_pk_bf16(P[BASE + 6], P[BASE + 7]);                              \
    auto r0 = __builtin_amdgcn_permlane32_swap(a0, b0, false, false); auto r1 = __builtin_amdgcn_permlane32_swap(a1, b1, false, false); \
    u32x4 w = {r0[0], r1[0], r0[1], r1[1]}; OUT = *reinterpret_cast<bf16x8*>(&w); } while (0)
    PK4(p0, 0, pa0); PK4(p0, 8, pa1); PK4(p1, 0, pa2); PK4(p1, 8, pa3);
#undef PK4
}
__device__ __forceinline__ void qkt(f32x16& p0, f32x16& p1, const char* Ks, const bf16x8* qr, int r32, int hi) {
    p0 = f32x16{}; p1 = f32x16{};
#pragma unroll
    for (int d0 = 0; d0 < 8; ++d0) { const int cb = (d0 * 16 + hi * 8) * 2;
        bf16x8 b0 = *reinterpret_cast<const bf16x8*>(Ks + KSWZ(r32, cb));
        bf16x8 b1 = *reinterpret_cast<const bf16x8*>(Ks + KSWZ(32 + r32, cb));
        p0 = __builtin_amdgcn_mfma_f32_32x32x16_bf16(b0, qr[d0], p0, 0, 0, 0);
        p1 = __builtin_amdgcn_mfma_f32_32x32x16_bf16(b1, qr[d0], p1, 0, 0, 0); }
}
__device__ __forceinline__ int v_st(int k, int c) { const int kk = (k & ~0xC) | ((k & 4) << 1) | ((k & 8) >> 1); return ((kk >> 3) * 4 + (c >> 5)) * 512 + ((kk & 7) * 32 + (c & 31)) * 2; }
__device__ __forceinline__ int v_rd_base(int lane) { return ((lane & 3) << 3) | (((lane >> 2) & 3) << 6) | (((lane >> 4) & 1) << 5) | (((lane >> 5) & 1) << 8); }
constexpr int v_rd_off(int d0, int ks, int half) { return d0 * 512 + ks * 4096 + half * 2048; }
template <int OFF> __device__ __forceinline__ s16x4 tr_read(int vb) {
    s16x4 r; asm volatile("ds_read_b64_tr_b16 %0, %1 offset:%2" : "=&v"(r) : "v"(vb), "i"(OFF) : "memory"); return r;
}
template <int D0> __device__ __forceinline__ void pv_one(f32x16& od, int vb, bf16x8 pa0, bf16x8 pa1, bf16x8 pa2, bf16x8 pa3) {
    const s16x4 l0 = tr_read<v_rd_off(D0, 0, 0)>(vb), h0 = tr_read<v_rd_off(D0, 0, 1)>(vb), l1 = tr_read<v_rd_off(D0, 1, 0)>(vb), h1 = tr_read<v_rd_off(D0, 1, 1)>(vb);
    const s16x4 l2 = tr_read<v_rd_off(D0, 2, 0)>(vb), h2 = tr_read<v_rd_off(D0, 2, 1)>(vb), l3 = tr_read<v_rd_off(D0, 3, 0)>(vb), h3 = tr_read<v_rd_off(D0, 3, 1)>(vb);
    asm volatile("s_waitcnt lgkmcnt(0)" ::: "memory"); SBAR();
#define PK(L, H) (bf16x8){L[0], L[1], L[2], L[3], H[0], H[1], H[2], H[3]}
    od = __builtin_amdgcn_mfma_f32_32x32x16_bf16(pa0, PK(l0, h0), od, 0, 0, 0);
    od = __builtin_amdgcn_mfma_f32_32x32x16_bf16(pa1, PK(l1, h1), od, 0, 0, 0);
    od = __builtin_amdgcn_mfma_f32_32x32x16_bf16(pa2, PK(l2, h2), od, 0, 0, 0);
    od = __builtin_amdgcn_mfma_f32_32x32x16_bf16(pa3, PK(l3, h3), od, 0, 0, 0);
#undef PK
}
__device__ __forceinline__ void pv_d0(f32x16* o, int vb, bf16x8 pa0, bf16x8 pa1, bf16x8 pa2, bf16x8 pa3) {
    pv_one<0>(o[0], vb, pa0, pa1, pa2, pa3); pv_one<1>(o[1], vb, pa0, pa1, pa2, pa3); pv_one<2>(o[2], vb, pa0, pa1, pa2, pa3); pv_one<3>(o[3], vb, pa0, pa1, pa2, pa3);
}
__device__ __forceinline__ void attn_group(const bf16_t* __restrict__ QB, int trow, int dst, int h, int kblk, bool mask, int ntl,
                                           bf16_t* __restrict__ OP, float* __restrict__ LSEp, const char* K_lds, const char* V_lds, float* ws) {
    const int lane = threadIdx.x & 63, r32 = lane & 31, hi = lane >> 5;
    float* li_l = ws; float* al_l = ws + 32; int* dst_l = (int*)(ws + 64);
    if (hi == 0) dst_l[r32] = dst;
    float m_reg = -1e30f, l_reg = 0; f32x16 o[4] = {}; bf16x8 qr[8];
    const bf16_t* Qw = QB + (size_t)trow * LDQ + h * HD + hi * 8;
#pragma unroll
    for (int d0 = 0; d0 < 8; ++d0) qr[d0] = *reinterpret_cast<const bf16x8*>(Qw + d0 * 16);
    const float slope = __builtin_amdgcn_exp2f(-(float)(h + 1)), coef = -slope / SCALE;
    float distb = (float)(trow - kblk * BLK - 4 * hi);
    int vb = (int)(uintptr_t)V_lds + v_rd_base(lane);
#define RESC(a) do { if (__any((a) < 1.f)) { if (hi == 0) al_l[r32] = (a); asm volatile("s_waitcnt lgkmcnt(0)" ::: "memory"); \
    _Pragma("unroll") for (int d = 0; d < 4; ++d) _Pragma("unroll") for (int r = 0; r < 16; ++r) o[d][r] *= al_l[crow(r, hi)]; } } while (0)
    if (ntl == 4) {
        f32x16 pA0, pA1, pB0, pB1; float mnA, mnB, alA, alB; bf16x8 pa0, pa1, pa2, pa3;
        qkt(pA0, pA1, K_lds, qr, r32, hi); bias_mask(pA0, pA1, distb, coef, mask); partialSM(pA0, pA1, m_reg, mnA, alA);
        SBAR(); qkt(pB0, pB1, K_lds + SHM_K, qr, r32, hi); bias_mask(pB0, pB1, distb - 64.f, coef, mask);
        finishSM(pA0, pA1, alA, l_reg, pa0, pa1, pa2, pa3); SBAR();
        pv_d0(o, vb, pa0, pa1, pa2, pa3); partialSM(pB0, pB1, m_reg, mnB, alB);
        RESC(alB);
        SBAR(); qkt(pA0, pA1, K_lds + 2 * SHM_K, qr, r32, hi); bias_mask(pA0, pA1, distb - 128.f, coef, mask);
        finishSM(pB0, pB1, alB, l_reg, pa0, pa1, pa2, pa3); SBAR();
        pv_d0(o, vb + SHM_V, pa0, pa1, pa2, pa3); partialSM(pA0, pA1, m_reg, mnA, alA);
        RESC(alA);
        SBAR(); qkt(pB0, pB1, K_lds + 3 * SHM_K, qr, r32, hi); bias_mask(pB0, pB1, distb - 192.f, coef, mask);
        finishSM(pA0, pA1, alA, l_reg, pa0, pa1, pa2, pa3); SBAR();
        pv_d0(o, vb + 2 * SHM_V, pa0, pa1, pa2, pa3); partialSM(pB0, pB1, m_reg, mnB, alB);
        RESC(alB);
        finishSM(pB0, pB1, alB, l_reg, pa0, pa1, pa2, pa3); SBAR();
        pv_d0(o, vb + 3 * SHM_V, pa0, pa1, pa2, pa3);
    } else {
        for (int tl = 0; tl < ntl; ++tl) {
            f32x16 p0, p1; float mn, al; bf16x8 pa0, pa1, pa2, pa3;
            qkt(p0, p1, K_lds + tl * SHM_K, qr, r32, hi); bias_mask(p0, p1, distb, coef, mask);
            partialSM(p0, p1, m_reg, mn, al);
            RESC(al);
            finishSM(p0, p1, al, l_reg, pa0, pa1, pa2, pa3); SBAR();
            pv_d0(o, vb, pa0, pa1, pa2, pa3);
            distb -= 64.f; vb += SHM_V;
        }
    }
#undef RESC
    if (hi == 0) { li_l[r32] = l_reg; if (dst >= 0) LSEp[dst] = m_reg * (SCALE * 1.4426950408889634f) + __builtin_amdgcn_logf(l_reg); }
    asm volatile("s_waitcnt lgkmcnt(0)" ::: "memory");
#pragma unroll
    for (int rp = 0; rp < 8; ++rp) {
        const int ra = 2 * rp, rb = 2 * rp + 1; const int rowa = crow(ra, hi), rowb = crow(rb, hi);
        const float ia = __builtin_amdgcn_rcpf(li_l[rowa]), ib = __builtin_amdgcn_rcpf(li_l[rowb]);
        const int da = dst_l[rowa], db = dst_l[rowb];
        const bool odd = lane & 1;
        const int dd = odd ? db : da;
        bf16_t* orow = OP + (size_t)(dd < 0 ? 0 : dd) * HD + (r32 & ~1);
#pragma unroll
        for (int d0 = 0; d0 < 4; ++d0) { const float va = o[d0][ra] * ia, vb2 = o[d0][rb] * ib;
            const float send = odd ? va : vb2; const float recv = __shfl_xor(send, 1);
            const unsigned w = odd ? cvt_pk_bf16(recv, vb2) : cvt_pk_bf16(va, recv);
            if (dd >= 0) *(unsigned*)(orow + d0 * 32) = w; }
    }
}
}

__device__ __forceinline__ void phase_attention(const Args& a, LAS unsigned char* ldsl, char* lds, bool second) {
    const int tid = threadIdx.x, wid = tid >> 6, lane = tid & 63, r32 = lane & 31;
    const bf16_t* QB = (const bf16_t*)(a.ws + WS_QB); const bf16_t* KB = (const bf16_t*)(a.ws + WS_KB); const bf16_t* VB = (const bf16_t*)(a.ws + WS_VB);
    const unsigned* acnt = (const unsigned*)(a.ws + WS_CTL) + CW_ACNT;
    unsigned* aq = (unsigned*)(a.ws + WS_CTL) + (second ? CW_AQ + 64 : CW_AQ);
    const int* alist = (const int*)(a.ws + WS_ALIST);
    bf16_t* OP = (bf16_t*)(a.ws + WS_OPART); float* LSE = (float*)(a.ws + WS_LSE);
    volatile LAS int* pfx = (volatile LAS int*)(ldsl + MISC_OFF + 2048);
    char* K_lds = lds; char* V_lds = lds + 65536;
    float* wsc = (float*)(lds + MISC_OFF + 4096) + wid * 128;
    if (tid < 256) { const int ng = (int)((acnt[tid * 64] + 31u) >> 5); int v = (ng + 15) >> 4;
#pragma unroll
        for (int o = 1; o < 64; o <<= 1) { const int t = __shfl_up(v, o); if (lane >= o) v += t; }
        pfx[1 + tid] = v; if (lane == 63) pfx[300 + wid] = v; }
    __syncthreads();
    if (tid < 256) { int add = 0; for (int w = 0; w < wid; ++w) add += pfx[300 + w]; pfx[1 + tid] += add; if (tid == 0) pfx[0] = 0; }
    if (tid == 0) pfx[310] = (int)atomicAdd(aq, 1u);
    __syncthreads();
    const int nsel = pfx[256], nitems = 256 + nsel;
    for (;;) {
        const int it = pfx[310];
        __syncthreads();
        if (it >= nitems) break;
        if (tid == 0) pfx[310] = (int)atomicAdd(aq, 1u);
        int h, kb, g0, g1, b = 0; bool mask;
        if (it < nsel) {
#pragma unroll
            for (int s = 128; s >= 1; s >>= 1) { if (pfx[b + s] <= it) b += s; }
            b = __builtin_amdgcn_readfirstlane(b);
            const int k = __builtin_amdgcn_readfirstlane(it - pfx[b]); h = b >> 5; kb = b & 31; mask = false;
            const int ng = (int)((acnt[b * 64] + 31u) >> 5); g0 = 16 * k; g1 = (g0 + 16 < ng) ? g0 + 16 : ng;
        } else { const int j = it - nsel; h = j >> 5; kb = j & 31; mask = true; g0 = 0; g1 = 8; }
        { const bf16_t* Kh = KB + (size_t)kb * BLK * DA + h * HD; const bf16_t* Vh = VB + (size_t)kb * BLK * DA + h * HD;
          const int sr = tid >> 4, sc = (tid & 15) * 8;
          bf16x8 kv[8], vv[8];
#pragma unroll
          for (int j = 0; j < 8; ++j) { kv[j] = *(const bf16x8*)(Kh + (size_t)(sr + 32 * j) * DA + sc); vv[j] = *(const bf16x8*)(Vh + (size_t)(sr + 32 * j) * DA + sc); }
#pragma unroll
          for (int j = 0; j < 8; ++j) { const int row = sr + 32 * j, tl = row >> 6, rr = row & 63;
              *(bf16x8*)(K_lds + tl * att::SHM_K + KSWZ(rr, sc * 2)) = kv[j]; *(bf16x8*)(V_lds + tl * att::SHM_V + att::v_st(rr, sc)) = vv[j]; } }
        __syncthreads();
        const int cnt = mask ? 0 : (int)acnt[b * 64];
        for (int g = g0 + wid; g < g1; g += 8) {
            int trow, dst, ntl = 4;
            if (mask) { trow = kb * BLK + g * 32 + r32; dst = (trow * NH + h) * 4 + 3; ntl = (g >> 1) + 1; }
            else { const int ei = g * 32 + r32; const bool valid = ei < cnt; const int ent = alist[(size_t)b * S + (valid ? ei : 0)];
                trow = ent & 0xffff; dst = valid ? (trow * NH + h) * 4 + (ent >> 16) : -1; }
            att::attn_group(QB, trow, dst, h, kb, mask, ntl, OP, LSE, K_lds, V_lds, wsc);
        }
    }
}

__device__ __forceinline__ void phase_attn_combine(const Args& a) {
    const int tid = threadIdx.x, wid = tid >> 6, lane = tid & 63;
    const bf16_t* OP = (const bf16_t*)(a.ws + WS_OPART); const float* LSE = (const float*)(a.ws + WS_LSE); bf16_t* MIX = (bf16_t*)(a.ws + WS_MIXIN);
    const int gw = blockIdx.x * NWAVES + wid, ngw = gridDim.x * NWAVES;
    constexpr int U = 4;
    for (int p0 = gw * U; p0 < S * NH; p0 += ngw * U) {
        f32x4 l[U]; unsigned v[U][4];
#pragma unroll
        for (int u = 0; u < U; ++u) l[u] = *(const f32x4*)(LSE + (size_t)(p0 + u) * 4);
#pragma unroll
        for (int u = 0; u < U; ++u)
#pragma unroll
            for (int s = 0; s < 4; ++s) v[u][s] = (l[u][s] > -INFINITY) ? *(const unsigned*)(OP + ((size_t)(p0 + u) * 4 + s) * HD + 2 * lane) : 0u;
#pragma unroll
        for (int u = 0; u < U; ++u) {
            const float M = fmaxf(fmaxf(l[u][0], l[u][1]), fmaxf(l[u][2], l[u][3]));
            float ws = 0.f, o0 = 0.f, o1 = 0.f;
#pragma unroll
            for (int s = 0; s < 4; ++s) { const float wgt = __builtin_amdgcn_exp2f(l[u][s] - M); ws += wgt; o0 += wgt * bf_lo(v[u][s]); o1 += wgt * bf_hi(v[u][s]); }
            const float inv = 1.f / ws;
            const int p = p0 + u, t = p >> 3, h = p & 7;
            *(unsigned*)(MIX + (size_t)t * DM + h * HD + 2 * lane) = cvt_pk_bf16(o0 * inv, o1 * inv);
        }
    }
}

__device__ __forceinline__ void phase_ln1_router(const Args& a, LAS unsigned char* lds, bool dry) {
    const int tid = threadIdx.x, wid = __builtin_amdgcn_readfirstlane(tid >> 6), lane = tid & 63;
    const bf16_t* H = (const bf16_t*)(a.ws + WS_H1);
    const float* g1 = a.in[I_LN1G]; const float* b1 = a.in[I_LN1B]; const float* br = a.in[I_BR];
    unsigned* ecnt = (unsigned*)(a.ws + WS_CTL) + (dry ? CW_ECNT2 : CW_ECNT);
    int* tokrow = (int*)(a.ws + (dry ? WS_QB : WS_TOKROW)); float* gatel = (float*)(a.ws + (dry ? WS_KB : WS_GATE)); int* toklist = (int*)(a.ws + (dry ? WS_VB : WS_TOKLIST)); bf16_t* HB = (bf16_t*)(a.ws + (dry ? WS_MIXIN : WS_H1B)); unsigned char* H8 = a.ws + (dry ? WS_UB : WS_H8);
    const bf16_t* wimg = (const bf16_t*)(a.ws + WS_WRT);
    LAS int* ecl = (LAS int*)(lds + MISC_OFF + 4096);
    LAS int* ebase = ecl + 32;
    LAS int* rinfo = ebase + 32;
    LAS float* rgate = (LAS float*)(rinfo + 128);
    for (int rb = blockIdx.x * 2; rb < S / 16; rb += gridDim.x * 2) {
      if (tid < 32) ecl[tid] = 0;
      for (int pass = 0; pass < 2; ++pass) {
        asm volatile("" : "+s"(g1), "+s"(b1), "+s"(wimg), "+s"(H), "+s"(HB), "+s"(H8));
        const int row0 = (rb + pass) * 16 + wid * 2;
        __syncthreads();
#pragma unroll
        for (int r = 0; r < 2; ++r) {
            const bf16_t* hp = H + (size_t)(row0 + r) * DM;
            f32x4 hv[4][2]; float s = 0.f;
#pragma unroll
            for (int j = 0; j < 4; ++j) { const u32x4 hw = *(const u32x4*)(hp + (64 * j + lane) * 8);
                hv[j][0] = (f32x4){bf_lo(hw.x), bf_hi(hw.x), bf_lo(hw.y), bf_hi(hw.y)}; hv[j][1] = (f32x4){bf_lo(hw.z), bf_hi(hw.z), bf_lo(hw.w), bf_hi(hw.w)};
#pragma unroll
                for (int hh = 0; hh < 2; ++hh) s += (hv[j][hh][0] + hv[j][hh][1]) + (hv[j][hh][2] + hv[j][hh][3]); }
            const float mean = wave_sum(s) * (1.f / DM); float s2 = 0.f;
#pragma unroll
            for (int j = 0; j < 4; ++j)
#pragma unroll
                for (int hh = 0; hh < 2; ++hh) { hv[j][hh] -= mean; const f32x4 d = hv[j][hh]; s2 += (d[0] * d[0] + d[1] * d[1]) + (d[2] * d[2] + d[3] * d[3]); }
            const float rstd = 1.f / sqrtf(wave_sum(s2) * (1.f / DM) + LN_EPS);
            bf16_t* hb = HB + (size_t)(row0 + r) * DM;
            const int lr = wid * 2 + r;
#pragma unroll
            for (int j = 0; j < 4; ++j) {
#pragma unroll
                for (int hh = 0; hh < 2; ++hh) { const int k = (64 * j + lane) * 8 + 4 * hh; const f32x4 gg = *(const f32x4*)(g1 + k), bb = *(const f32x4*)(b1 + k);
                    hv[j][hh] = hv[j][hh] * rstd * gg + bb; }
                const f32x4 x0 = hv[j][0], x1 = hv[j][1];
                u32x4 w; w.x = cvt_pk_bf16(x0[0], x0[1]); w.y = cvt_pk_bf16(x0[2], x0[3]); w.z = cvt_pk_bf16(x1[0], x1[1]); w.w = cvt_pk_bf16(x1[2], x1[3]);
                *(u32x4*)(hb + (64 * j + lane) * 8) = w;
                u32x2 w8; w8.x = cvt4_fp8(x0[0] * SC_H, x0[1] * SC_H, x0[2] * SC_H, x0[3] * SC_H); w8.y = cvt4_fp8(x1[0] * SC_H, x1[1] * SC_H, x1[2] * SC_H, x1[3] * SC_H);
                *(u32x2*)(H8 + (size_t)(row0 + r) * DM + (64 * j + lane) * 8) = w8;
                u32x4 wl; wl.x = cvt_pk_bf16(x0[0] - bf_lo(w.x), x0[1] - bf_hi(w.x)); wl.y = cvt_pk_bf16(x0[2] - bf_lo(w.y), x0[3] - bf_hi(w.y));
                wl.z = cvt_pk_bf16(x1[0] - bf_lo(w.z), x1[1] - bf_hi(w.z)); wl.w = cvt_pk_bf16(x1[2] - bf_lo(w.w), x1[3] - bf_hi(w.w));
                const int off = lr * 4096 + (((64 * j + lane) ^ (lr & 15)) * 16);
                *(LAS u32x4*)(lds + off) = w; *(LAS u32x4*)(lds + 65536 + off) = wl;
                asm volatile("" ::: "memory"); }
        }
        __syncthreads();
        f32x4 lg0 = (f32x4){0.f, 0.f, 0.f, 0.f}, lg1 = lg0;
        { const int arow = lane & 15, kq = lane >> 4;
#pragma unroll
          for (int si = 0; si < 8; ++si) { const int ss = wid * 8 + si;
              const int aoff = arow * 4096 + (((4 * ss + kq) ^ arow) * 16);
              const bf16x8 ah = *(const LAS bf16x8*)(lds + aoff), al = *(const LAS bf16x8*)(lds + 65536 + aoff);
              const bf16_t* wp = wimg + ((size_t)(ss * 2) * 64 + lane) * 8;
              const bf16x8 bh0 = *(const bf16x8*)wp, bh1 = *(const bf16x8*)(wp + 512), bl0 = *(const bf16x8*)(wp + DM * NE), bl1 = *(const bf16x8*)(wp + DM * NE + 512);
              lg0 = __builtin_amdgcn_mfma_f32_16x16x32_bf16(ah, bh0, lg0, 0, 0, 0); lg0 = __builtin_amdgcn_mfma_f32_16x16x32_bf16(ah, bl0, lg0, 0, 0, 0); lg0 = __builtin_amdgcn_mfma_f32_16x16x32_bf16(al, bh0, lg0, 0, 0, 0);
              lg1 = __builtin_amdgcn_mfma_f32_16x16x32_bf16(ah, bh1, lg1, 0, 0, 0); lg1 = __builtin_amdgcn_mfma_f32_16x16x32_bf16(ah, bl1, lg1, 0, 0, 0); lg1 = __builtin_amdgcn_mfma_f32_16x16x32_bf16(al, bh1, lg1, 0, 0, 0); } }
        __syncthreads();
        { LAS float* part = (LAS float*)lds + wid * 512;
#pragma unroll
          for (int q = 0; q < 4; ++q) { const int prow = 4 * (lane >> 4) + q; part[prow * 32 + (lane & 15)] = lg0[q]; part[prow * 32 + 16 + (lane & 15)] = lg1[q]; } }
        __syncthreads();
        const int e = lane & 31, rr = lane >> 5;
        float lg = br[e];
#pragma unroll
        for (int w8 = 0; w8 < 8; ++w8) lg += ((const LAS float*)lds)[w8 * 512 + (wid * 2 + rr) * 32 + e];
        int sel_e[4]; float sel_v[4]; float gcur = lg;
#pragma unroll
        for (int s = 0; s < 4; ++s) { float bv = gcur; int bi = e;
#pragma unroll
            for (int o = 1; o < 32; o <<= 1) { const float ov = __shfl_xor(bv, o, 32); const int oi = __shfl_xor(bi, o, 32); if (ov > bv || (ov == bv && oi < bi)) { bv = ov; bi = oi; } }
            sel_e[s] = bi; sel_v[s] = bv; if (e == bi) gcur = -INFINITY; }
        float ex[4], es = 0.f;
#pragma unroll
        for (int s = 0; s < 4; ++s) { ex[s] = __expf(sel_v[s] - sel_v[0]); es += ex[s]; }
        const float einv = 1.f / es;
        const int lrow = pass * 16 + wid * 2 + rr;
#pragma unroll
        for (int s = 0; s < 4; ++s) { if (e == sel_e[s]) { const int rank = __hip_atomic_fetch_add(ecl + e, 1, __ATOMIC_RELAXED, __HIP_MEMORY_SCOPE_WORKGROUP);
            rinfo[lrow * 4 + s] = (e << 16) | rank; rgate[lrow * 4 + s] = ex[s] * einv; } }
      }
      VM_WAIT(); __syncthreads();
      if (tid < 32) { const int c = ecl[tid]; ebase[tid] = c > 0 ? (int)atomicAdd(ecnt + tid * 64, (unsigned)c) : 0; }
      __syncthreads();
      if (tid < 128) { const int cidx = tid, lrow = cidx >> 2; const int info = rinfo[cidx]; const int e = info >> 16;
          const int drow = e * ECAP + ebase[e] + (info & 0xffff); const int t = rb * 16 + lrow;
          gatel[drow] = rgate[cidx]; toklist[drow] = t; tokrow[(size_t)t * 4 + (cidx & 3)] = drow; }
      __syncthreads();
    }
}

__device__ __forceinline__ void phase_final(const Args& a) {
    const int tid = threadIdx.x, wid = tid >> 6, lane = tid & 63;
    const bf16_t* HB = (const bf16_t*)(a.ws + WS_H1B); const unsigned char* Y = a.ws + WS_XG; const int* tokrow = (const int*)(a.ws + WS_TOKROW);
    const float* g2 = a.in[I_LN2G]; const float* b2 = a.in[I_LN2B]; float* out = a.out;
    const int gw = blockIdx.x * NWAVES + wid, ngw = gridDim.x * NWAVES;
    typedef int i32x4 __attribute__((ext_vector_type(4)));
    constexpr int U = 2;
    for (int t0 = gw * U; t0 < S; t0 += ngw * U) {
        asm volatile("" : "+s"(g2), "+s"(b2), "+s"(out), "+s"(HB), "+s"(Y));
        i32x4 tr[U];
#pragma unroll
        for (int u = 0; u < U; ++u) tr[u] = *(const i32x4*)(tokrow + (size_t)(t0 + u) * 4);
        u32x4 hb[U][4]; u32x2 yr[U][4][4];
#pragma unroll
        for (int u = 0; u < U; ++u)
#pragma unroll
            for (int j = 0; j < 4; ++j) { const int k = (64 * j + lane) * 8; hb[u][j] = *(const u32x4*)(HB + (size_t)(t0 + u) * DM + k);
#pragma unroll
                for (int s = 0; s < 4; ++s) yr[u][j][s] = *(const u32x2*)(Y + (size_t)tr[u][s] * DM + k); }
#pragma unroll
        for (int u = 0; u < U; ++u) {
            const int t = t0 + u;
            f32x4 v[4][2]; float sm = 0.f;
#pragma unroll
            for (int j = 0; j < 4; ++j) { const u32x4 h4 = hb[u][j];
                f32x4 x0 = (f32x4){bf_lo(h4.x), bf_hi(h4.x), bf_lo(h4.y), bf_hi(h4.y)} * DN_ALPHA, x1 = (f32x4){bf_lo(h4.z), bf_hi(h4.z), bf_lo(h4.w), bf_hi(h4.w)} * DN_ALPHA;
#pragma unroll
                for (int s = 0; s < 4; ++s) { const u32x2 y = yr[u][j][s]; constexpr float iy = 1.f / SC_Y;
                    const f32x2 a0 = __builtin_amdgcn_cvt_pk_f32_fp8((int)y.x, false), a1 = __builtin_amdgcn_cvt_pk_f32_fp8((int)y.x, true), a2 = __builtin_amdgcn_cvt_pk_f32_fp8((int)y.y, false), a3 = __builtin_amdgcn_cvt_pk_f32_fp8((int)y.y, true);
                    x0[0] += a0[0] * iy; x0[1] += a0[1] * iy; x0[2] += a1[0] * iy; x0[3] += a1[1] * iy; x1[0] += a2[0] * iy; x1[1] += a2[1] * iy; x1[2] += a3[0] * iy; x1[3] += a3[1] * iy; }
                v[j][0] = x0; v[j][1] = x1; sm += (x0[0] + x0[1]) + (x0[2] + x0[3]) + (x1[0] + x1[1]) + (x1[2] + x1[3]); }
            const float mean = wave_sum(sm) * (1.f / DM); float s2 = 0.f;
#pragma unroll
            for (int j = 0; j < 4; ++j)
#pragma unroll
                for (int hh = 0; hh < 2; ++hh) { v[j][hh] -= mean; const f32x4 d = v[j][hh]; s2 += (d[0] * d[0] + d[1] * d[1]) + (d[2] * d[2] + d[3] * d[3]); }
            const float rstd = 1.f / sqrtf(wave_sum(s2) * (1.f / DM) + LN_EPS);
#pragma unroll
            for (int j = 0; j < 4; ++j)
#pragma unroll
                for (int hh = 0; hh < 2; ++hh) { const int k = (64 * j + lane) * 8 + 4 * hh; const f32x4 gg = *(const f32x4*)(g2 + k), bb = *(const f32x4*)(b2 + k);
                    *(f32x4*)(out + (size_t)t * DM + k) = v[j][hh] * rstd * gg + bb; }
        }
    }
}

__global__ void __launch_bounds__(NTHR, 2) hybrid_fwd(Args args) {
    extern __shared__ __attribute__((aligned(16))) unsigned char lds_raw[];
    LAS unsigned char* lds = (LAS unsigned char*)lds_raw;
    volatile LAS unsigned* MISC = (volatile LAS unsigned*)(lds + MISC_OFF);
    const int tid = threadIdx.x;
    if (tid < 64) MISC[tid] = 0u;
    __syncthreads();
    unsigned char* ws = args.ws;
    const int lo = args.ph_lo, hi = args.ph_hi;
    XcdBarrier bar; bar.bar = (unsigned*)(ws + WS_CTL) + CW_BAR; bar.x = 0; bar.st = nullptr;
    if (hi - lo > 1) bar = xcd_barrier_post((unsigned*)(ws + WS_CTL) + CW_BAR, MISC + 8);
#ifndef PH_MASK
#define PH_MASK 0x3ff
#endif
#define IN(k) (((PH_MASK >> (k)) & 1) && lo <= (k) && (k) < hi)
    volatile LAS int* cqb = (volatile LAS int*)(lds + MISC_OFF + 256);
#define SEAM(k) do { if (IN(k) && IN((k) + 1)) { if ((k) == 1) { cq_while_waiting(args, lds, cqb, (unsigned)gridDim.x, CQ_N); cq_drain(args, lds, cqb, CQ_N); } xcd_barrier(bar); } } while (0)

#ifndef PH_REPEAT
#define PH_REPEAT 0
#endif
#define REP(k) ((PH_REPEAT >> (k)) & 1)
#define RUN(k, ...) do { if (IN(k)) { __VA_ARGS__; if (REP(k)) { xcd_barrier(bar); __VA_ARGS__; } } } while (0)
    RUN(0, phase_convert(args, lds));
    SEAM(0);
    RUN(1, {
        { const int r = (int)(blockIdx.x >> 3) - (32 - CV_P1_WGS / 8);
          if (r >= 0) { constexpr int per = CV_P1 / CV_P1_WGS; const int k = r * 8 + (int)(blockIdx.x & 7); moe_convert_items(args, lds, k * per, per); __syncthreads(); } }
        pg8::DenseOrder So; So.init(S, INCOLS, gridDim.x, blockIdx.x, ws + WS_XB, ws + WS_WINT); So.q = (unsigned*)(ws + WS_CTL) + CW_GQ;
        pg8::EpiInProj E{(bf16_t*)(ws + WS_QB), (bf16_t*)(ws + WS_UB), (float*)(ws + WS_CTL + CTL_KSUM)};
        pg8::gemm_phase<pg8::EpiInProj, pg8::DenseOrder>(lds, So, E, (LAS int*)(lds + MISC_OFF + 4096));
    });
    SEAM(1);
    if (IN(2)) { phase_gate_conv(args, lds, false); if (REP(2)) { xcd_barrier(bar); phase_gate_conv(args, lds, true); } }
    SEAM(2);
    if (IN(3)) {
        { const int r = (int)(blockIdx.x >> 3) - (32 - CV_P3_WGS / 8);
          if (r >= 0) { constexpr int per = (TI_GU - CV_P1) / CV_P3_WGS; const int k = r * 8 + (int)(blockIdx.x & 7);
              { f32x4 vw[8]; for (int it = TI_WIN + k; it < TI_WIN + TI_WOUT; it += CV_P3_WGS) { const TItem ia = t_decode(args, it); t_load(ia, vw, tid); t_process(ia, vw, lds, tid); } }
              moe_convert_items(args, lds, CV_P1 + k * per, per); __syncthreads(); } }
        phase_attention(args, lds, (char*)lds_raw, false); if (REP(3)) { xcd_barrier(bar); phase_attention(args, lds, (char*)lds_raw, true); } }
    SEAM(3);
    RUN(4, phase_attn_combine(args));
    SEAM(4);
    RUN(5, {
        pg8::DenseOrder So; So.init(S, DM, gridDim.x, blockIdx.x, ws + WS_MIXIN, ws + WS_WOUTT); So.q = nullptr;
        pg8::EpiOutProj E{args.in[I_X], (bf16_t*)(ws + WS_H1)};
        pg8::gemm_phase<pg8::EpiOutProj, pg8::DenseOrder>(lds, So, E, (LAS int*)(lds + MISC_OFF + 4096));
    });
    SEAM(5);
    if (IN(6)) { phase_ln1_router(args, lds, false); if (REP(6)) { xcd_barrier(bar); phase_ln1_router(args, lds, true); } }
    SEAM(6);
    if (IN(7) || IN(8)) {
        volatile LAS int* pfx = (volatile LAS int*)(lds + MISC_OFF + 512);
        if (tid < 64) { const unsigned* ecnt = (const unsigned*)(ws + WS_CTL) + CW_ECNT; int v = (tid < NE) ? (int)((ecnt[(tid & 31) * 64] + 255u) >> 8) : 0;
#pragma unroll
            for (int o = 1; o < 64; o <<= 1) { const int t = __shfl_up(v, o); if ((tid & 63) >= o) v += t; }
            if (tid < NE) { pfx[1 + tid] = v; pfx[40 + tid] = (int)ecnt[tid * 64]; } if (tid == 0) pfx[0] = 0; }
        __syncthreads();
        RUN(7, {
            { const int r = (int)(blockIdx.x >> 3) - (32 - CV_P7_WGS / 8);
              if (r >= 0) { constexpr int per = (TI_D + CV_P7_WGS - 1) / CV_P7_WGS; const int k = r * 8 + (int)(blockIdx.x & 7); const int f = k * per; const int n = (f + per <= TI_D) ? per : (TI_D > f ? TI_D - f : 0);
                  moe_convert_items_deep(args, lds, TI_GU + f, n); __syncthreads(); } }
            pg8::MoeOrder So{pfx, 16, (int)gridDim.x, (int)blockIdx.x, (const char*)(ws + WS_H8), (const char*)(ws + WS_WGUT), 0, (size_t)4096 * 2048, (size_t)256 * 2048, (const int*)(ws + WS_TOKLIST), (unsigned)S, (unsigned*)(ws + WS_CTL) + CW_GQ + 16 * 64};
            pg8::EpiGateUp E{ws + WS_ACT, args.in[I_BGU]};
            pg8::gemm_phase<pg8::EpiGateUp, pg8::MoeOrder, true, true>(lds, So, E, (LAS int*)(lds + MISC_OFF + 4096));
        });
        SEAM(7);
        RUN(8, {
            pg8::MoeOrder So{pfx, 8, (int)gridDim.x, (int)blockIdx.x, (const char*)(ws + WS_ACT), (const char*)(ws + WS_WDT), 0, (size_t)2048 * 2048, (size_t)256 * 2048, (const int*)(ws + WS_IDLIST), (unsigned)(NE * ECAP), nullptr};
            pg8::EpiDown E{ws + WS_XG, args.in[I_BD], (const float*)(ws + WS_GATE)};
            pg8::gemm_phase<pg8::EpiDown, pg8::MoeOrder, true, true>(lds, So, E, (LAS int*)(lds + MISC_OFF + 4096));
        });
    }
    SEAM(8);
    RUN(9, phase_final(args));
#undef IN
#undef SEAM
}

extern "C" void kernel_launch(void* const* d_in, const int* in_sizes, int n_in, void* d_out, int out_size, void* d_ws, size_t ws_size, hipStream_t stream) {
    static int grid = 0;
    if (grid == 0) {
        if (n_in != 17 || in_sizes[0] != S * DM || out_size != S * DM || ws_size < WS_END) {
            fprintf(stderr, "kernel_launch: built for 17 inputs, x/out of %d floats, >= %zu bytes of workspace; got n_in %d, in0 %d, out %d, ws %zu; nothing launched\n", S * DM, (size_t)WS_END, n_in, n_in > 0 ? in_sizes[0] : -1, out_size, ws_size);
            grid = -1; return; }
        int dev = 0, cus = 0, per_cu = 0;
        if (hipGetDevice(&dev) != hipSuccess || hipDeviceGetAttribute(&cus, hipDeviceAttributeMultiprocessorCount, dev) != hipSuccess) { fprintf(stderr, "kernel_launch: device query failed\n"); grid = -1; return; }
        if (hipFuncSetAttribute((const void*)hybrid_fwd, hipFuncAttributeMaxDynamicSharedMemorySize, LDS_BYTES) != hipSuccess) { fprintf(stderr, "kernel_launch: hipFuncSetAttribute failed\n"); grid = -1; return; }
        if (hipOccupancyMaxActiveBlocksPerMultiprocessor(&per_cu, (const void*)hybrid_fwd, NTHR, LDS_BYTES) != hipSuccess || per_cu < 1)
            fprintf(stderr, "kernel_launch: note: occupancy query reports %d workgroups per CU\n", per_cu);
        (void)hipGetLastError();
        grid = cus;
    }
    if (grid < 0) return;
    if (hipMemsetAsync((char*)d_ws + WS_CTL, 0, CTL_ZERO_BYTES, stream) != hipSuccess) { fprintf(stderr, "kernel_launch: memset failed\n"); return; }
    Args a{};
    for (int i = 0; i < 17; ++i) a.in[i] = (const float*)d_in[i];
    a.out = (float*)d_out; a.ws = (unsigned char*)d_ws;
#if MK_N_LAUNCHES == 1
    a.ph_lo = 0; a.ph_hi = NPHASE;
    hipLaunchKernelGGL(hybrid_fwd, dim3(grid), dim3(NTHR), LDS_BYTES, stream, a);
#else
    for (int p = 0; p < NPHASE; ++p) { a.ph_lo = p; a.ph_hi = p + 1; hipLaunchKernelGGL(hybrid_fwd, dim3(grid), dim3(NTHR), LDS_BYTES, stream, a); }
#endif
    const hipError_t le = hipPeekAtLastError();
    if (le != hipSuccess) fprintf(stderr, "kernel_launch: launch failed: %s\n", hipGetErrorName(le));
}
```

```cpp
#include <hip/hip_runtime.h>
#include <cstdio>
#include <cstdint>

#ifndef MK_N_LAUNCHES
#define MK_N_LAUNCHES 1
#endif

#define GAS __attribute__((address_space(1)))
#define LAS __attribute__((address_space(3)))
typedef unsigned short bf16_t;
typedef short bf16x8 __attribute__((ext_vector_type(8)));
typedef short s16x4 __attribute__((ext_vector_type(4)));
typedef float f32x4 __attribute__((ext_vector_type(4)));
typedef float f32x2 __attribute__((ext_vector_type(2)));
typedef float f32x16 __attribute__((ext_vector_type(16)));
typedef unsigned u32x4 __attribute__((ext_vector_type(4)));
typedef unsigned u32x2 __attribute__((ext_vector_type(2)));

constexpr int S = 8192, DM = 2048, DA = 1024, DC = 1024, NH = 8, HD = 128, NBLK = 32, BLK = 256;
constexpr int NE = 32, DFF = 2048, INCOLS = 5120, CONVW = 31;
constexpr int ECAP = 8192;
constexpr float LN_EPS = 1e-5f;
constexpr float DN_ALPHA = 1.189207115002721f;
constexpr float SC_W = 64.f, SC_H = 8.f, SC_ACT = 4.f, SC_Y = 64.f;
constexpr int NWAVES = 8, NTHR = 512;
constexpr int NPHASE = 10;

constexpr size_t MiB = 1u << 20;
constexpr size_t WS_CTL = 0, CTL_ZERO_BYTES = 1 * MiB;
constexpr size_t WS_XB = 1 * MiB;
constexpr size_t WS_WINT = 33 * MiB;
constexpr size_t WS_WOUTT = 53 * MiB;
constexpr size_t WS_QB = 61 * MiB;
constexpr size_t WS_KB = 77 * MiB;
constexpr size_t WS_VB = 93 * MiB;
constexpr size_t WS_UB = 109 * MiB;
constexpr size_t WS_ALIST = 125 * MiB;
constexpr size_t WS_LSE = 133 * MiB;
constexpr size_t WS_OPART = 134 * MiB;
constexpr size_t WS_MIXIN = 198 * MiB;
constexpr size_t WS_H1 = 230 * MiB;
constexpr size_t WS_TOKROW = 294 * MiB;
constexpr size_t WS_GATE = 295 * MiB;
constexpr size_t WS_WGUT = 296 * MiB;
constexpr size_t WS_WDT = 808 * MiB;
constexpr size_t WS_XG = 1064 * MiB;
constexpr size_t WS_ACT = 2088 * MiB;
constexpr size_t WS_H1B = 3112 * MiB;
constexpr size_t WS_WRT = 3144 * MiB;
constexpr size_t WS_TOKLIST = 3145 * MiB;
constexpr size_t WS_H8 = 3146 * MiB;
constexpr size_t WS_IDLIST = 3162 * MiB;
constexpr size_t WS_END = 3163 * MiB;
constexpr int CW_BAR = 4096;
constexpr int CW_ECNT = 8192;
constexpr int CW_CQ = 12416, CW_READY = 12480;
constexpr int CW_GQ = 49152;
constexpr int CW_AQ = 12288;
constexpr int CW_ECNT2 = 10240, CW_ACNT2 = 32768;
constexpr int CW_ACNT = 16384;
constexpr size_t CTL_KSUM = 262144;

constexpr int RING_BYTES = 131072;
constexpr int MISC_OFF = RING_BYTES;
constexpr int LDS_BYTES = RING_BYTES + 12288;

__device__ __forceinline__ unsigned cvt_pk_bf16(float lo, float hi) { unsigned r; asm volatile("v_cvt_pk_bf16_f32 %0, %1, %2" : "=v"(r) : "v"(lo), "v"(hi)); return r; }
__device__ __forceinline__ unsigned cvt4_fp8(float a, float b, float c, float d) {
    a = __builtin_amdgcn_fmed3f(a, -448.f, 448.f); b = __builtin_amdgcn_fmed3f(b, -448.f, 448.f); c = __builtin_amdgcn_fmed3f(c, -448.f, 448.f); d = __builtin_amdgcn_fmed3f(d, -448.f, 448.f);
    int w = __builtin_amdgcn_cvt_pk_fp8_f32(a, b, 0, false); w = __builtin_amdgcn_cvt_pk_fp8_f32(c, d, w, true); return (unsigned)w; }
__device__ __forceinline__ float bf_lo(unsigned w) { return __builtin_bit_cast(float, w << 16); }
__device__ __forceinline__ float bf_hi(unsigned w) { return __builtin_bit_cast(float, w & 0xffff0000u); }
__device__ __forceinline__ float wave_sum(float v) {
#pragma unroll
    for (int o = 1; o < 64; o <<= 1) v += __shfl_xor(v, o);
    return v;
}
__device__ __forceinline__ float fast_sigmoid(float x) { return __builtin_amdgcn_rcpf(1.f + __builtin_amdgcn_exp2f(-x * 1.4426950408889634f)); }
#define VM_WAIT() asm volatile("s_waitcnt vmcnt(0)" ::: "memory")
#define LDS_WAIT() asm volatile("s_waitcnt lgkmcnt(0)" ::: "memory")

#define XB_TMO      128
#define XB_XCNT(j)  (256  + 64 * (j))
#define XB_XSUB(j)  (1280 + 64 * (j))
#define XB_XGEN(j)  (2304 + 64 * (j))
#define XB_TOP      3328
#define XB_TOPGEN   3392
#define XCD_BAR_WORDS 3456
#define XB_SPIN_CAP (1u << 18)
__device__ __forceinline__ unsigned xb_ld(unsigned* p)              { return __hip_atomic_load(p, __ATOMIC_RELAXED, __HIP_MEMORY_SCOPE_AGENT); }
__device__ __forceinline__ unsigned xb_add(unsigned* p, unsigned v) { return __hip_atomic_fetch_add(p, v, __ATOMIC_RELAXED, __HIP_MEMORY_SCOPE_AGENT); }
__device__ __forceinline__ unsigned xb_xcc_id() { return (unsigned)__builtin_amdgcn_s_getreg((3 << 11) | 20) & 0xFu; }
#define XB_SPIN(cond, bar) do { unsigned _sp = 0; while (cond) { __builtin_amdgcn_s_sleep(1); \
    if ((++_sp & 255u) == 0u) { if (xb_ld(&(bar)[XB_TMO])) break; if (_sp > XB_SPIN_CAP) { atomicAdd(&(bar)[XB_TMO], 1u); break; } } } } while (0)
struct XcdBarrier { unsigned* bar; unsigned x; volatile LAS unsigned* st; };
__device__ __forceinline__ XcdBarrier xcd_barrier_post(unsigned* bar, volatile LAS unsigned* st) {
    XcdBarrier b; b.bar = bar; b.x = xb_xcc_id(); b.st = st;
    if (threadIdx.x == 0) (void)xb_add(&bar[XB_XCNT(b.x)], 1u);
    return b;
}
__device__ __forceinline__ void xcd_barrier_complete(unsigned* bar, unsigned x, unsigned& nloc, unsigned& nx) {
    const unsigned G = gridDim.x * gridDim.y * gridDim.z;
    unsigned sum, cnt, mine, sp = 0u;
    for (;;) {
        sum = 0u; cnt = 0u; mine = 0u;
#pragma unroll
        for (unsigned j = 0; j < 16; ++j) { const unsigned c = xb_ld(&bar[XB_XCNT(j)]); sum += c; cnt += (c > 0u) ? 1u : 0u; mine = (j == x) ? c : mine; }
        if (sum == G) break;
        __builtin_amdgcn_s_sleep(1);
        if ((++sp & 255u) == 0u) { if (xb_ld(&bar[XB_TMO])) break; if (sp > XB_SPIN_CAP) { atomicAdd(&bar[XB_TMO], 1u); break; } }
    }
    nloc = mine > 0u ? mine : 1u; nx = cnt > 0u ? cnt : 1u;
}
__device__ __forceinline__ void xcd_barrier(const XcdBarrier& b) {
    asm volatile("s_waitcnt vmcnt(0)" ::: "memory");
    __syncthreads();
    if (threadIdx.x == 0) {
        unsigned* bar = b.bar;
        __builtin_amdgcn_s_waitcnt(0);
        unsigned nloc = b.st[0], nx = b.st[1];
        if (nloc == 0u) { xcd_barrier_complete(bar, b.x, nloc, nx); b.st[0] = nloc; b.st[1] = nx; }
        const unsigned old = xb_add(&bar[XB_XSUB(b.x)], 1u);
        const unsigned gen = old / nloc;
        if (old + 1u == (gen + 1u) * nloc) {
            __builtin_amdgcn_fence(__ATOMIC_RELEASE, "agent");
            asm volatile("s_waitcnt vmcnt(0)" ::: "memory");
            const unsigned og = xb_add(&bar[XB_TOP], 1u);
            const unsigned tg = og / nx;
            if (og + 1u == (tg + 1u) * nx) xb_add(&bar[XB_TOPGEN], 1u);
            else XB_SPIN(xb_ld(&bar[XB_TOPGEN]) == tg, bar);
            __builtin_amdgcn_fence(__ATOMIC_ACQUIRE, "agent");
            xb_add(&bar[XB_XGEN(b.x)], 1u);
            asm volatile("s_waitcnt vmcnt(0)" ::: "memory");
        } else {
            XB_SPIN(xb_ld(&bar[XB_XGEN(b.x)]) == gen, bar);
            __builtin_amdgcn_fence(__ATOMIC_ACQUIRE, "agent");
            asm volatile("s_waitcnt vmcnt(0)" ::: "memory");
        }
    }
    __syncthreads();
}

namespace pg8 {
constexpr int BM = 256, BK = 64, HALF = 128, HTB = HALF * BK * 2, STAGE_BYTES = 8 * HTB, NXCD = 8, WGM = 8;
constexpr int GK = 2048, S_ROWS = 8192;
__host__ __device__ __forceinline__ int lds_byte(int r, int c) { const int st = (r >> 4) * 2 + (c >> 5), rr = r & 15, cc = c & 31, ob = rr * 64 + cc * 2; return st * 1024 + (ob ^ (((ob >> 9) & 1) << 5)); }
__host__ __device__ __forceinline__ void stage_rc(int b, int& R, int& C) { const int st = b / 1024, sb = b % 1024, swz = sb ^ (((sb >> 9) & 1) << 5); R = (st >> 1) * 16 + swz / 64; C = (st & 1) * 32 + (swz % 64) / 2; }
__host__ __device__ __forceinline__ int perm32(int rho) { const int n = rho >> 4, i = rho & 15; return 8 * (i >> 2) + 4 * n + (i & 3); }

struct Unit { const char* A; const char* B; const int* tok; int pm, pn, e; int half; };
constexpr size_t TSTEP = (size_t)BM * GK * 2;

struct DenseOrder {
    int nM, nN, nwg, G, c; const char* A; const char* Bt; static constexpr unsigned maxrow = 1u;
    __device__ void init(int M, int N, int G_, int c_, const void* A_, const void* Bt_) { nM = M / BM; nN = N / BM; nwg = nM * nN; G = G_; c = c_; A = (const char*)A_; Bt = (const char*)Bt_; }
    unsigned* q;
    __device__ __forceinline__ bool decode(int L, Unit& u) const {
        if (L >= nwg) return false;
        int wgid = L; { const int q = nwg / NXCD, r = nwg % NXCD, xcd = wgid % NXCD, off = wgid / NXCD; wgid = (xcd < r ? xcd * (q + 1) : r * (q + 1) + (xcd - r) * q) + off; }
        const int nig = WGM * nN, gid = wgid / nig, fm = gid * WGM, gsz = (nM - fm) < WGM ? (nM - fm) : WGM;
        u.pm = fm + ((wgid % nig) % gsz); u.pn = (wgid % nig) / gsz; u.e = 0;
        u.A = A + (size_t)u.pm * TSTEP; u.B = Bt + (size_t)u.pn * TSTEP; u.tok = nullptr; return true;
    }
};
struct MoeOrder {
    const volatile LAS int* pfx; int npn, G, c; const char* A; const char* Bt; size_t a_es, b_es; size_t ts  ; const int* toklist; unsigned maxrow  ;
    unsigned* q;
    __device__ __forceinline__ bool decode(int L, Unit& u) const {
        const int total = pfx[NE] * npn; if (L >= total) return false;
        const int gm = L / npn, pn = L - gm * npn;
        int e = 0;
#pragma unroll
        for (int s = 16; s >= 1; s >>= 1) { if (pfx[e + s] <= gm) e += s; }
        e = __builtin_amdgcn_readfirstlane(e);
        const int mt = __builtin_amdgcn_readfirstlane(gm - pfx[e]);
        u.pm = mt; u.pn = pn; u.e = e; u.half = __builtin_amdgcn_readfirstlane((pfx[40 + e] - mt * BM) <= HALF ? 1 : 0);
        u.A = toklist ? A : A + (size_t)e * a_es + (size_t)mt * ts; u.B = Bt + (size_t)e * b_es + (size_t)pn * ts; u.tok = toklist ? toklist + (size_t)e * ECAP + mt * BM : nullptr; return true;
    }
};

typedef int v8i __attribute__((ext_vector_type(8)));
template <class Epi, class Sched, bool GATHER = false, bool FP8 = false>
__device__ __forceinline__ void gemm_phase(LAS unsigned char* lds, const Sched& S, const Epi& E, LAS int* tokl) {
    const int tid = threadIdx.x, wid = __builtin_amdgcn_readfirstlane(tid >> 6), lane = tid & 63, wr = wid >> 2, wc = wid & 3, fr = lane & 15, fq = lane >> 4;
    constexpr int K = FP8 ? GK / 2 : GK, nt = K / BK;
    unsigned vc[2][2], voffB[2];
#pragma unroll
    for (int i = 0; i < 2; ++i) { int R, C; stage_rc(tid * 16 + i * 8192, R, C); const int Rb = Epi::PERM ? ((R & ~31) + perm32(R & 31)) : R;
        voffB[i] = (unsigned)(Rb * K + C) * 2u;
#pragma unroll
        for (int h = 0; h < 2; ++h) vc[h][i] = (unsigned)((R + HALF * h) * K + C) * 2u; }
#define PG8_GATHER_OFFS(TOKPTR) do { int _tz = threadIdx.x; asm volatile("" : "+v"(_tz)); _Pragma("unroll") for (int _i = 0; _i < 2; ++_i) { int _R, _C; stage_rc(_tz * 16 + _i * 8192, _R, _C); \
        _Pragma("unroll") for (int _h = 0; _h < 2; ++_h) { unsigned _tk = (unsigned)(TOKPTR)[_R + HALF * _h]; _tk = _tk < S.maxrow ? _tk : S.maxrow - 1u; vc[_h][_i] = (_tk * K + (unsigned)_C) * 2u; } } } while (0)
    constexpr size_t kstep = (size_t)(BK * 2);
    constexpr size_t hstep = (size_t)HALF * K * 2;
    const unsigned ldsw = (unsigned)wid * 1024u;
    const int aoff = lds_byte(wr * 64 + fr, fq * 8), boff = lds_byte(wc * 32 + fr, fq * 8);
#define PG8_SA(b, h) (((b) * 2 + (h)) * HTB)
#define PG8_SB(b, h) ((4 + (b) * 2 + (h)) * HTB)
#define PG8_STAGE(bufoff, gbase, voff) do { _Pragma("unroll") for (int _i = 0; _i < 2; ++_i) \
        __builtin_amdgcn_global_load_lds((const unsigned*)((const char*)(gbase) + (voff)[_i]), (LAS unsigned*)(lds + (bufoff) + ldsw + _i * 8192), 16, 0, 0); } while (0)
#define PG8_LDA(dst, b, h) do { _Pragma("unroll") for (int m = 0; m < 4; ++m) _Pragma("unroll") for (int k = 0; k < 2; ++k) dst[m][k] = *(const LAS bf16x8*)(lds + PG8_SA(b, h) + aoff + m * 2048 + k * 1024); } while (0)
#define PG8_LDB(dst, b, h) do { _Pragma("unroll") for (int n = 0; n < 2; ++n) _Pragma("unroll") for (int k = 0; k < 2; ++k) dst[n][k] = *(const LAS bf16x8*)(lds + PG8_SB(b, h) + boff + n * 2048 + k * 1024); } while (0)
struct Frag2 { bf16x8 a, b; };
#define PG8_CAT(x) (Frag2{x[0], x[1]})
#define PG8_MMA(ai, bj, At, Bt) do { __builtin_amdgcn_s_setprio(1); _Pragma("unroll") for (int m = 0; m < 4; ++m) _Pragma("unroll") for (int n = 0; n < 2; ++n) { \
        if constexpr (FP8) acc[ai][bj][m][n] = __builtin_amdgcn_mfma_scale_f32_16x16x128_f8f6f4(__builtin_bit_cast(v8i, PG8_CAT(Bt[n])), __builtin_bit_cast(v8i, PG8_CAT(At[m])), acc[ai][bj][m][n], 0, 0, 0, 0x7f7f7f7f, 0, 0x7f7f7f7f); \
        else { _Pragma("unroll") for (int k = 0; k < 2; ++k) acc[ai][bj][m][n] = __builtin_amdgcn_mfma_f32_16x16x32_bf16(Bt[n][k], At[m][k], acc[ai][bj][m][n], 0, 0, 0); } } \
        __builtin_amdgcn_s_setprio(0); } while (0)
#define PG8_WAIT_V(n) asm volatile("s_waitcnt vmcnt(" #n ")" ::: "memory")
#define PG8_WAIT_L(n) asm volatile("s_waitcnt lgkmcnt(" #n ")" ::: "memory")
#define PG8_BAR __builtin_amdgcn_s_barrier()
#define PG8_SCHED __builtin_amdgcn_sched_barrier(0)
    const int label = blockIdx.x & 7; unsigned* qp = S.q + label * 64; const bool dyn = S.q != nullptr;
    volatile LAS int* qs = (volatile LAS int*)(tokl + 2 * BM);
    int jnxt;
    if (dyn) { if (tid == 0) qs[0] = (int)xb_add(qp, 2u); __syncthreads(); jnxt = qs[0] + 1; }
    else jnxt = (int)(blockIdx.x >> 3) + 1;
    Unit cur, nxt; int ui = 0;
    if (!S.decode((jnxt - 1) * 8 + label, cur)) return;
    if (!dyn) jnxt += 31;
    f32x4 acc[2][2][4][2];
#pragma unroll
    for (int a = 0; a < 2; ++a)
#pragma unroll
        for (int b = 0; b < 2; ++b)
#pragma unroll
            for (int m = 0; m < 4; ++m)
#pragma unroll
                for (int n = 0; n < 2; ++n) acc[a][b][m][n] = (f32x4){0.f, 0.f, 0.f, 0.f};
    bf16x8 At[4][2], B0[2][2], B1[2][2];
    const char* cA = cur.A; const char* cB = cur.B;
    if constexpr (GATHER) PG8_GATHER_OFFS(cur.tok);
    PG8_STAGE(PG8_SB(0, 0), cB, voffB); PG8_STAGE(PG8_SB(0, 1), cB + hstep, voffB); PG8_STAGE(PG8_SA(0, 0), cA, vc[0]); PG8_STAGE(PG8_SA(0, 1), cA, vc[1]);
    if (wr == 1) PG8_BAR;
    PG8_WAIT_V(2); PG8_BAR;
    PG8_STAGE(PG8_SB(1, 0), cB + kstep, voffB); PG8_STAGE(PG8_SA(1, 0), cA + kstep, vc[0]); PG8_STAGE(PG8_SB(1, 1), cB + hstep + kstep, voffB);
    PG8_WAIT_V(6); PG8_BAR;
    for (;;) {
        const bool has_next = S.decode(jnxt * 8 + label, nxt);
        unsigned jreq = 0u;
        if (dyn && tid == 0) jreq = xb_add(qp, 1u);
        const char* nA = has_next ? nxt.A : cA; const char* nB = has_next ? nxt.B : cB;
        if constexpr (GATHER) {
            if (has_next && wid == 0) __builtin_amdgcn_global_load_lds((const unsigned*)(nxt.tok + lane * 4), (LAS unsigned*)(tokl + ((ui + 1) & 1) * BM), 16, 0, 0);
        }
        if (GATHER && FP8 && cur.half != 0) {
            for (int t = 0; t < nt; t += 2) {
                const bool last = (t == nt - 2);
                const char* a1 = cA + (size_t)(t + 1) * kstep;
                const char* a2 = last ? nA : cA + (size_t)(t + 2) * kstep; const char* b2 = last ? nB : cB + (size_t)(t + 2) * kstep;
                const char* a3 = a2 + kstep; const char* b3 = b2 + kstep;
                PG8_LDB(B0, 0, 0); PG8_LDB(B1, 0, 1); PG8_SCHED; PG8_LDA(At, 0, 0); PG8_STAGE(PG8_SA(1, 1), a1, vc[1]);
                if constexpr (GATHER) { if (last && has_next) PG8_GATHER_OFFS(tokl + ((ui + 1) & 1) * BM); }
                if (dyn && last && tid == 0) { asm volatile("" : "+v"(jreq)); qs[1 + (ui & 1)] = (int)jreq; }
                PG8_WAIT_V(8); PG8_WAIT_L(0); PG8_BAR; PG8_MMA(0, 0, At, B0); PG8_MMA(0, 1, At, B1); PG8_BAR; PG8_SCHED;
                PG8_STAGE(PG8_SB(0, 0), b2, voffB); PG8_STAGE(PG8_SB(0, 1), b2 + hstep, voffB); PG8_STAGE(PG8_SA(0, 0), a2, vc[0]);
                PG8_WAIT_V(8); PG8_WAIT_L(0); PG8_BAR; asm volatile("s_nop 7\n\ts_nop 7" ::: "memory"); PG8_BAR; PG8_SCHED;
                PG8_LDB(B0, 1, 0); PG8_LDB(B1, 1, 1); PG8_SCHED; PG8_LDA(At, 1, 0); PG8_STAGE(PG8_SA(0, 1), a2, vc[1]);
                PG8_WAIT_V(8); PG8_WAIT_L(0); PG8_BAR; PG8_MMA(0, 0, At, B0); PG8_MMA(0, 1, At, B1); PG8_BAR; PG8_SCHED;
                PG8_STAGE(PG8_SB(1, 0), b3, voffB); PG8_STAGE(PG8_SB(1, 1), b3 + hstep, voffB); PG8_STAGE(PG8_SA(1, 0), a3, vc[0]);
                PG8_WAIT_V(8); PG8_WAIT_L(0); PG8_BAR; asm volatile("s_nop 7\n\ts_nop 7" ::: "memory"); PG8_BAR; PG8_SCHED;
            }
        } else {
            for (int t = 0; t < nt; t += 2) {
                const bool last = (t == nt - 2);
                const char* a1 = cA + (size_t)(t + 1) * kstep;
                const char* a2 = last ? nA : cA + (size_t)(t + 2) * kstep; const char* b2 = last ? nB : cB + (size_t)(t + 2) * kstep;
                const char* a3 = a2 + kstep; const char* b3 = b2 + kstep;
                PG8_LDB(B0, 0, 0); PG8_LDB(B1, 0, 1); PG8_SCHED; PG8_LDA(At, 0, 0); PG8_STAGE(PG8_SA(1, 1), a1, vc[1]);
                if constexpr (GATHER) { if (last && has_next) PG8_GATHER_OFFS(tokl + ((ui + 1) & 1) * BM); }
                if (dyn && last && tid == 0) { asm volatile("" : "+v"(jreq)); qs[1 + (ui & 1)] = (int)jreq; }
                PG8_WAIT_V(8); PG8_WAIT_L(0); PG8_BAR; PG8_MMA(0, 0, At, B0); PG8_MMA(0, 1, At, B1); PG8_BAR; PG8_SCHED;
                PG8_LDA(At, 0, 1); PG8_STAGE(PG8_SB(0, 0), b2, voffB); PG8_STAGE(PG8_SB(0, 1), b2 + hstep, voffB); PG8_STAGE(PG8_SA(0, 0), a2, vc[0]);
                PG8_WAIT_V(8); PG8_WAIT_L(0); PG8_BAR; PG8_MMA(1, 0, At, B0); PG8_MMA(1, 1, At, B1); PG8_BAR; PG8_SCHED;
                PG8_LDB(B0, 1, 0); PG8_LDB(B1, 1, 1); PG8_SCHED; PG8_LDA(At, 1, 0); PG8_STAGE(PG8_SA(0, 1), a2, vc[1]);
                PG8_WAIT_V(8); PG8_WAIT_L(0); PG8_BAR; PG8_MMA(0, 0, At, B0); PG8_MMA(0, 1, At, B1); PG8_BAR; PG8_SCHED;
                PG8_LDA(At, 1, 1); PG8_STAGE(PG8_SB(1, 0), b3, voffB); PG8_STAGE(PG8_SB(1, 1), b3 + hstep, voffB); PG8_STAGE(PG8_SA(1, 0), a3, vc[0]);
                PG8_WAIT_V(8); PG8_WAIT_L(0); PG8_BAR; PG8_MMA(1, 0, At, B0); PG8_MMA(1, 1, At, B1); PG8_BAR; PG8_SCHED;
            }
        }
        if (wr == 0) PG8_BAR;
        { int tz = threadIdx.x; asm volatile("" : "+v"(tz)); const int lz = tz & 63; E(acc, cur, wr, wc, lz & 15, lz >> 4); }
        if (!has_next) break;
#pragma unroll
        for (int a = 0; a < 2; ++a)
#pragma unroll
            for (int b = 0; b < 2; ++b)
#pragma unroll
                for (int m = 0; m < 4; ++m)
#pragma unroll
                    for (int n = 0; n < 2; ++n) acc[a][b][m][n] = (f32x4){0.f, 0.f, 0.f, 0.f};
        jnxt = dyn ? qs[1 + (ui & 1)] : jnxt + 32;
        cur = nxt; cA = nA; cB = nB; ++ui;
        if (wr == 1) PG8_BAR;
    }
    PG8_WAIT_V(0);
    PG8_BAR;
#undef PG8_SA
#undef PG8_SB
#undef PG8_STAGE
#undef PG8_LDA
#undef PG8_LDB
#undef PG8_MMA
#undef PG8_CAT
#undef PG8_GATHER_OFFS
#undef PG8_WAIT_V
#undef PG8_WAIT_L
#undef PG8_BAR
#undef PG8_SCHED
}

struct EpiInProj {
    static constexpr bool PERM = true;
    bf16_t *Q, *U; float* ksum;
    __device__ __forceinline__ void operator()(const f32x4 (&acc)[2][2][4][2], const Unit& u, int wr, int wc, int fr, int fq) const {
        const int row0 = u.pm * BM + wr * 64 + fr;
        if (u.pn < 12) {
            const int t = u.pn >> 2; bf16_t* base = Q + (size_t)t * ((WS_KB - WS_QB) / 2);
            const int col0 = (u.pn & 3) * 256 + wc * 32 + 8 * fq;
#pragma unroll
            for (int ai = 0; ai < 2; ++ai)
#pragma unroll
                for (int m = 0; m < 4; ++m) { bf16_t* rowp = base + (size_t)(row0 + ai * HALF + m * 16) * DA + col0;
#pragma unroll
                    for (int bj = 0; bj < 2; ++bj) { const f32x4 v0 = acc[ai][bj][m][0], v1 = acc[ai][bj][m][1];
                        u32x4 w; w.x = cvt_pk_bf16(v0[0], v0[1]); w.y = cvt_pk_bf16(v0[2], v0[3]); w.z = cvt_pk_bf16(v1[0], v1[1]); w.w = cvt_pk_bf16(v1[2], v1[3]);
                        *(u32x4*)(rowp + bj * HALF) = w; } }
            if (t == 1) {
#pragma unroll
                for (int bj = 0; bj < 2; ++bj)
#pragma unroll
                    for (int n = 0; n < 2; ++n) { f32x4 s = (f32x4){0.f, 0.f, 0.f, 0.f};
#pragma unroll
                        for (int ai = 0; ai < 2; ++ai)
#pragma unroll
                            for (int m = 0; m < 4; ++m) s += acc[ai][bj][m][n];
#pragma unroll
                        for (int e = 0; e < 4; ++e) { float v = s[e]; v += __shfl_xor(v, 1); v += __shfl_xor(v, 2); v += __shfl_xor(v, 4); v += __shfl_xor(v, 8);
                            if (fr == 0) atomicAdd(ksum + (size_t)u.pm * DA + col0 + bj * HALF + 4 * n + e, v); } }
            }
        } else {
            const int ch0 = (u.pn - 12) * 128 + wc * 32 + 8 * fq;
#pragma unroll
            for (int ai = 0; ai < 2; ++ai)
#pragma unroll
                for (int m = 0; m < 4; ++m) { bf16_t* rowp = U + (size_t)(row0 + ai * HALF + m * 16) * DC + ch0;
                    float o[8];
#pragma unroll
                    for (int n = 0; n < 2; ++n)
#pragma unroll
                        for (int e = 0; e < 4; ++e) o[n * 4 + e] = acc[ai][0][m][n][e] * fast_sigmoid(acc[ai][1][m][n][e]);
                    u32x4 w; w.x = cvt_pk_bf16(o[0], o[1]); w.y = cvt_pk_bf16(o[2], o[3]); w.z = cvt_pk_bf16(o[4], o[5]); w.w = cvt_pk_bf16(o[6], o[7]);
                    *(u32x4*)rowp = w; }
        }
    }
};
struct EpiOutProj {
    static constexpr bool PERM = true;
    const bf16_t* X; bf16_t* H;
    __device__ __forceinline__ void operator()(const f32x4 (&acc)[2][2][4][2], const Unit& u, int wr, int wc, int fr, int fq) const {
        const int row0 = u.pm * BM + wr * 64 + fr, col0 = u.pn * BM + wc * 32 + 8 * fq;
#pragma unroll
        for (int ai = 0; ai < 2; ++ai)
#pragma unroll
            for (int m = 0; m < 4; ++m) { const size_t off = (size_t)(row0 + ai * HALF + m * 16) * DM + col0;
#pragma unroll
                for (int bj = 0; bj < 2; ++bj) { const u32x4 xw = *(const u32x4*)(X + off + bj * HALF);
                    const f32x4 x0 = (f32x4){bf_lo(xw.x), bf_hi(xw.x), bf_lo(xw.y), bf_hi(xw.y)}, x1 = (f32x4){bf_lo(xw.z), bf_hi(xw.z), bf_lo(xw.w), bf_hi(xw.w)};
                    const f32x4 v0 = x0 * DN_ALPHA + acc[ai][bj][m][0], v1 = x1 * DN_ALPHA + acc[ai][bj][m][1];
                    u32x4 w; w.x = cvt_pk_bf16(v0[0], v0[1]); w.y = cvt_pk_bf16(v0[2], v0[3]); w.z = cvt_pk_bf16(v1[0], v1[1]); w.w = cvt_pk_bf16(v1[2], v1[3]);
                    *(u32x4*)(H + off + bj * HALF) = w; } }
    }
};
struct EpiGateUp {
    static constexpr bool PERM = true;
    unsigned char* ACT; const float* bias;
    __device__ __forceinline__ void operator()(const f32x4 (&acc)[2][2][4][2], const Unit& u, int wr, int wc, int fr, int fq) const {
        const int row0 = u.pm * BM + wr * 64 + fr, ch0 = u.pn * 128 + wc * 32 + 8 * fq;
        const float* bg = bias + (size_t)u.e * 4096 + ch0;
        f32x4 bgv[2], buv[2];
#pragma unroll
        for (int n = 0; n < 2; ++n) { bgv[n] = *(const f32x4*)(bg + 4 * n); buv[n] = *(const f32x4*)(bg + 2048 + 4 * n); }
        unsigned char* base = ACT + (size_t)u.e * ECAP * DFF;
        constexpr float inv = 1.f / (SC_H * SC_W);
#pragma unroll
        for (int ai = 0; ai < 2; ++ai)
#pragma unroll
            for (int m = 0; m < 4; ++m) { unsigned char* rowp = base + (size_t)(row0 + ai * HALF + m * 16) * DFF + ch0;
                float o[8];
#pragma unroll
                for (int n = 0; n < 2; ++n)
#pragma unroll
                    for (int e = 0; e < 4; ++e) { float g = acc[ai][0][m][n][e] * inv + bgv[n][e], uu = acc[ai][1][m][n][e] * inv + buv[n][e];
                        g = fminf(g, 7.f); uu = fminf(fmaxf(uu, -7.f), 7.f);
                        o[n * 4 + e] = (uu + 1.f) * (g * fast_sigmoid(1.702f * g)) * SC_ACT; }
                u32x2 w; w.x = cvt4_fp8(o[0], o[1], o[2], o[3]); w.y = cvt4_fp8(o[4], o[5], o[6], o[7]);
                *(u32x2*)rowp = w; }
    }
};
struct EpiDown {
    static constexpr bool PERM = true;
    unsigned char* Y; const float* bias; const float* gate;
    __device__ __forceinline__ void operator()(const f32x4 (&acc)[2][2][4][2], const Unit& u, int wr, int wc, int fr, int fq) const {
        const int row0 = u.pm * BM + wr * 64 + fr, col0 = u.pn * BM + wc * 32 + 8 * fq;
        const float* bb = bias + (size_t)u.e * DM + col0;
        unsigned char* base = Y + (size_t)u.e * ECAP * DM; const float* gp = gate + (size_t)u.e * ECAP;
        constexpr float inv = 1.f / (SC_ACT * SC_W);
#pragma unroll
        for (int bj = 0; bj < 2; ++bj) { const f32x4 b0 = *(const f32x4*)(bb + bj * HALF), b1 = *(const f32x4*)(bb + bj * HALF + 4);
#pragma unroll
            for (int ai = 0; ai < 2; ++ai)
#pragma unroll
                for (int m = 0; m < 4; ++m) { const int row = row0 + ai * HALF + m * 16; const float gt = gp[row] * SC_Y;
                    const f32x4 v0 = (acc[ai][bj][m][0] * inv + b0) * gt, v1 = (acc[ai][bj][m][1] * inv + b1) * gt;
                    u32x2 w; w.x = cvt4_fp8(v0[0], v0[1], v0[2], v0[3]); w.y = cvt4_fp8(v1[0], v1[1], v1[2], v1[3]);
                    *(u32x2*)(base + (size_t)row * DM + col0 + bj * HALF) = w; }
            asm volatile("" ::: "memory"); }
    }
};
}

struct Args { const float* in[17]; float* out; unsigned char* ws; int ph_lo, ph_hi; };
enum { I_X = 0, I_WIN, I_CONVW, I_CONVB, I_CLNG, I_CLNB, I_WOUT, I_LN1G, I_LN1B, I_WR, I_BR, I_WGU, I_BGU, I_WD, I_BD, I_LN2G, I_LN2B };

__device__ __forceinline__ int rowmap(int mode, int n) {
    if (mode == 1) {
        if (n < 3072) return n;
        if (n < 4096) { const int c = n - 3072; return 3072 + (c >> 7) * 256 + (c & 127); }
        const int c = n - 4096; return 3072 + (c >> 7) * 256 + 128 + (c & 127);
    }
    if (mode == 2) {
        if (n < 2048) return (n >> 7) * 256 + (n & 127);
        const int c = n - 2048; return (c >> 7) * 256 + 128 + (c & 127);
    }
    return n;
}
struct TItem { const float* src; bf16_t* dst; int N, mode, k0, n0; };
constexpr int TI_WIN = 32 * 20, TI_WOUT = 32 * 8, TI_GU = 32 * 32 * 16, TI_D = 32 * 32 * 8, TI_ALL = TI_WIN + TI_WOUT + TI_GU + TI_D;
__device__ __forceinline__ TItem t_decode(const Args& a, int it) {
    TItem r;
    if (it < TI_WIN) { r.src = a.in[I_WIN]; r.dst = (bf16_t*)(a.ws + WS_WINT); r.N = INCOLS; r.mode = 1; r.k0 = (it / 20) * 64; r.n0 = (it % 20) * 256; return r; }
    it -= TI_WIN;
    if (it < TI_WOUT) { r.src = a.in[I_WOUT]; r.dst = (bf16_t*)(a.ws + WS_WOUTT); r.N = DM; r.mode = 0; r.k0 = (it / 8) * 64; r.n0 = (it % 8) * 256; return r; }
    it -= TI_WOUT;
    if (it < TI_GU) { const int e = it / 512, j = it % 512; r.src = a.in[I_WGU] + (size_t)e * 2048 * 4096; r.dst = (bf16_t*)(a.ws + WS_WGUT + (size_t)e * 4096 * 2048); r.N = 4096; r.mode = 2; r.k0 = (j / 32) * 128; r.n0 = (j % 32) * 128; return r; }
    it -= TI_GU;
    { const int e = it / 256, j = it % 256; r.src = a.in[I_WD] + (size_t)e * 2048 * 2048; r.dst = (bf16_t*)(a.ws + WS_WDT + (size_t)e * 2048 * 2048); r.N = 2048; r.mode = 0; r.k0 = (j / 16) * 128; r.n0 = (j % 16) * 128; return r; }
}
__device__ __forceinline__ void t_load(const TItem& it, f32x4 (&v)[8], int tid) {
    const int kq = tid >> 6, nl = tid & 63;
    const float* p = it.src + (size_t)(it.k0 + kq * 8) * it.N + it.n0 + 4 * nl;
#pragma unroll
    for (int i = 0; i < 8; ++i) v[i] = *(const f32x4*)(p + (size_t)i * it.N);
}
__device__ __forceinline__ void t_process(const TItem& it, const f32x4 (&v)[8], LAS unsigned char* scr, int tid) {
    const int kq = tid >> 6, nl = tid & 63;
#pragma unroll
    for (int j = 0; j < 4; ++j) { u32x4 w; w.x = cvt_pk_bf16(v[0][j], v[1][j]); w.y = cvt_pk_bf16(v[2][j], v[3][j]); w.z = cvt_pk_bf16(v[4][j], v[5][j]); w.w = cvt_pk_bf16(v[6][j], v[7][j]);
        *(LAS u32x4*)(scr + (4 * nl + j) * 128 + ((kq ^ (nl & 7)) * 16)) = w; }
    __syncthreads();
#pragma unroll
    for (int p = 0; p < 4; ++p) { const int r = tid + 512 * p, nn = r >> 3, ch = r & 7;
        const u32x4 w = *(const LAS u32x4*)(scr + nn * 128 + ((ch ^ ((nn >> 2) & 7)) * 16));
        const int row = rowmap(it.mode, it.n0 + nn);
        *(u32x4*)(it.dst + (size_t)row * 2048 + it.k0 + ch * 8) = w; }
    __syncthreads();
}
__device__ __forceinline__ void t8_load(const TItem& it, f32x4 (&v)[8], int tid) {
    const int kq = tid >> 5, nl = tid & 31;
    const float* p = it.src + (size_t)(it.k0 + kq * 8) * it.N + it.n0 + 4 * nl;
#pragma unroll
    for (int i = 0; i < 8; ++i) v[i] = __builtin_nontemporal_load((const f32x4*)(p + (size_t)i * it.N));
}
template <bool SYNC2 = true> __device__ __forceinline__ void t8_process(const TItem& it, const f32x4 (&v)[8], LAS unsigned char* scr, int tid) {
    const int kq = tid >> 5, nl = tid & 31;
#pragma unroll
    for (int j = 0; j < 4; ++j) { u32x2 w; w.x = cvt4_fp8(v[0][j] * SC_W, v[1][j] * SC_W, v[2][j] * SC_W, v[3][j] * SC_W); w.y = cvt4_fp8(v[4][j] * SC_W, v[5][j] * SC_W, v[6][j] * SC_W, v[7][j] * SC_W);
        *(LAS u32x2*)(scr + (4 * nl + j) * 128 + (((kq >> 1) ^ (nl & 7)) * 16) + (kq & 1) * 8) = w; }
    __syncthreads();
#pragma unroll
    for (int p = 0; p < 2; ++p) { const int r = tid + 512 * p, nn = r >> 3, ch = r & 7;
        const u32x4 w = *(const LAS u32x4*)(scr + nn * 128 + ((ch ^ ((nn >> 2) & 7)) * 16));
        const int row = rowmap(it.mode, it.n0 + nn);
        __builtin_nontemporal_store(w, (u32x4*)((unsigned char*)it.dst + (size_t)row * 2048 + it.k0 + ch * 16)); }
    if (SYNC2) __syncthreads();
}
constexpr int CQ_N = 0;
constexpr int CV_P1 = 10240, CV_P1_WGS = 128, CV_P7_WGS = 96, CV_P3_WGS = 128;
__device__ __forceinline__ void phase_convert(const Args& a, LAS unsigned char* lds) {
    const int tid = threadIdx.x, G = gridDim.x, c = blockIdx.x;
    { const f32x4* src = (const f32x4*)a.in[I_X]; u32x4* dst = (u32x4*)(a.ws + WS_XB); const size_t n8 = (size_t)S * DM / 8;
      const size_t step = (size_t)G * NTHR;
      for (size_t i0 = (size_t)c * NTHR + tid; i0 < n8; i0 += 4 * step) { f32x4 p[4], q[4];
#pragma unroll
          for (int u = 0; u < 4; ++u) { const size_t i = i0 + u * step; if (i < n8) { p[u] = __builtin_nontemporal_load(src + 2 * i); q[u] = __builtin_nontemporal_load(src + 2 * i + 1); } }
#pragma unroll
          for (int u = 0; u < 4; ++u) { const size_t i = i0 + u * step; if (i < n8) {
              u32x4 w; w.x = cvt_pk_bf16(p[u][0], p[u][1]); w.y = cvt_pk_bf16(p[u][2], p[u][3]); w.z = cvt_pk_bf16(q[u][0], q[u][1]); w.w = cvt_pk_bf16(q[u][2], q[u][3]); dst[i] = w; } } } }
    { int* idl = (int*)(a.ws + WS_IDLIST); for (int i = c * NTHR + tid; i < NE * ECAP; i += G * NTHR) idl[i] = i; }
    { const float* wr = a.in[I_WR]; bf16_t* img = (bf16_t*)(a.ws + WS_WRT);
      for (int idx = c * NTHR + tid; idx < DM * NE; idx += G * NTHR) { const int j = idx & 7, l = (idx >> 3) & 63, et = (idx >> 9) & 1, ss = idx >> 10;
          const float w = wr[(size_t)(32 * ss + 8 * (l >> 4) + j) * NE + 16 * et + (l & 15)];
          const unsigned hi = cvt_pk_bf16(w, 0.f) & 0xffffu; const float wl = w - bf_lo(hi);
          img[idx] = (bf16_t)hi; img[DM * NE + idx] = (bf16_t)(cvt_pk_bf16(wl, 0.f) & 0xffffu); } }
    f32x4 va[8], vb[8];
    constexpr int TI_BF = TI_WIN + TI_WOUT;
    for (int it = c; it < TI_WIN; it += G) { const TItem ia = t_decode(a, it); t_load(ia, va, tid); t_process(ia, va, lds, tid); }
    int it = TI_BF + TI_GU + c;
    constexpr int TI_ALL0 = TI_BF + TI_GU;
    if (it < TI_ALL0) { TItem ia = t_decode(a, it); t8_load(ia, va, tid);
        for (;;) {
            const int itb = it + G; TItem ib; const bool hb = itb < TI_ALL0; if (hb) { ib = t_decode(a, itb); t8_load(ib, vb, tid); }
            t8_process(ia, va, lds, tid);
            if (!hb) break;
            const int ita = itb + G; const bool ha = ita < TI_ALL0; if (ha) { ia = t_decode(a, ita); t8_load(ia, va, tid); }
            t8_process(ib, vb, lds, tid);
            if (!ha) break;
            it = ita;
        }
    }
}
__device__ __forceinline__ void moe_convert_items(const Args& a, LAS unsigned char* lds, int first, int n) {
    constexpr int TI_BF = TI_WIN + TI_WOUT;
    const int tid = threadIdx.x;
    f32x4 va[8], vb[8], vc[8];
    const int it0 = TI_BF + first, itend = TI_BF + first + n;
    TItem ia, ib, ic;
    if (it0 < itend) { ia = t_decode(a, it0); t8_load(ia, va, tid); }
    if (it0 + 1 < itend) { ib = t_decode(a, it0 + 1); t8_load(ib, vb, tid); }
    for (int it = it0; it < itend; it += 3) {
        if (it + 2 < itend) { ic = t_decode(a, it + 2); t8_load(ic, vc, tid); }
        t8_process<false>(ia, va, lds + ((it - it0) & 1) * 16384, tid);
        if (it + 1 >= itend) break;
        if (it + 3 < itend) { ia = t_decode(a, it + 3); t8_load(ia, va, tid); }
        t8_process<false>(ib, vb, lds + ((it - it0 + 1) & 1) * 16384, tid);
        if (it + 2 >= itend) break;
        if (it + 4 < itend) { ib = t_decode(a, it + 4); t8_load(ib, vb, tid); }
        t8_process<false>(ic, vc, lds + ((it - it0) & 1) * 16384, tid);
    }
    __syncthreads();
}
constexpr int CQ_CHUNK = 2, TI_MOE = TI_GU + TI_D;
__device__ __forceinline__ void cq_drain(const Args& a, LAS unsigned char* lds, volatile LAS int* bc, int limit) {
    unsigned* cq = (unsigned*)(a.ws + WS_CTL) + CW_CQ;
    for (;;) {
        if (threadIdx.x == 0) { int q = -1; if ((int)xb_ld(cq) < limit) { q = (int)xb_add(cq, CQ_CHUNK); if (q >= limit) q = -1; } bc[0] = q; }
        __syncthreads(); const int q = bc[0]; __syncthreads();
        if (q < 0) break;
        moe_convert_items(a, lds, q, CQ_CHUNK);
    }
}
__device__ __forceinline__ void cq_while_waiting(const Args& a, LAS unsigned char* lds, volatile LAS int* bc, unsigned target, int limit) {
    unsigned* cq = (unsigned*)(a.ws + WS_CTL) + CW_CQ; unsigned* ready = (unsigned*)(a.ws + WS_CTL) + CW_READY;
    __syncthreads();
    if (threadIdx.x == 0) (void)xb_add(ready, 1u);
    for (;;) {
        if (threadIdx.x == 0) { int q = -1; if (xb_ld(ready) + 2u < target && (int)xb_ld(cq) < limit) { q = (int)xb_add(cq, CQ_CHUNK); if (q >= limit) q = -1; } bc[0] = q; }
        __syncthreads(); const int q = bc[0]; __syncthreads();
        if (q < 0) break;
        moe_convert_items(a, lds, q, CQ_CHUNK);
    }
}

__device__ __forceinline__ void phase_gate_conv(const Args& a, LAS unsigned char* lds, bool dry) {
    const int tid = threadIdx.x, wid = __builtin_amdgcn_readfirstlane(tid >> 6), lane = tid & 63;
    const bf16_t* QB = (const bf16_t*)(a.ws + WS_QB);
    const float* ksum = (const float*)(a.ws + WS_CTL + CTL_KSUM);
    unsigned* acnt = (unsigned*)(a.ws + WS_CTL) + (dry ? CW_ACNT2 : CW_ACNT);
    int* alist = (int*)(a.ws + (dry ? WS_ACT : WS_ALIST));
    float* LSE = (float*)(a.ws + (dry ? WS_ACT + 16 * MiB : WS_LSE));
    LAS int* lcnt = (LAS int*)(lds + MISC_OFF + 4096);
    LAS int* lbase = lcnt + 256;
    LAS int* selb = lbase + 256;
    for (int chunk = blockIdx.x; chunk < S / 32; chunk += gridDim.x) {
        const int qb = chunk >> 3;
        const int h = wid;
        if (tid < 256) lcnt[tid] = 0;
        __syncthreads();
        const int r32 = lane & 31, hi = lane >> 5;
        const float* kp = ksum + (size_t)r32 * DA + h * HD + hi * 8;
        const bf16_t* qp = QB + (size_t)(chunk * 32 + r32) * DA + h * HD + hi * 8;
        f32x16 sc = {};
#pragma unroll
        for (int ss = 0; ss < 8; ++ss) {
            const f32x4 k0 = *(const f32x4*)(kp + ss * 16), k1 = *(const f32x4*)(kp + ss * 16 + 4);
            const bf16x8 qf = *(const bf16x8*)(qp + ss * 16);
            u32x4 ah, al;
            ah.x = cvt_pk_bf16(k0[0], k0[1]); ah.y = cvt_pk_bf16(k0[2], k0[3]); ah.z = cvt_pk_bf16(k1[0], k1[1]); ah.w = cvt_pk_bf16(k1[2], k1[3]);
            al.x = cvt_pk_bf16(k0[0] - bf_lo(ah.x), k0[1] - bf_hi(ah.x)); al.y = cvt_pk_bf16(k0[2] - bf_lo(ah.y), k0[3] - bf_hi(ah.y));
            al.z = cvt_pk_bf16(k1[0] - bf_lo(ah.z), k1[1] - bf_hi(ah.z)); al.w = cvt_pk_bf16(k1[2] - bf_lo(ah.w), k1[3] - bf_hi(ah.w));
            sc = __builtin_amdgcn_mfma_f32_32x32x16_bf16(__builtin_bit_cast(bf16x8, ah), qf, sc, 0, 0, 0);
            sc = __builtin_amdgcn_mfma_f32_32x32x16_bf16(__builtin_bit_cast(bf16x8, al), qf, sc, 0, 0, 0);
        }
        float v[16];
#pragma unroll
        for (int r = 0; r < 16; ++r) { const int nb = (r & 3) + 8 * (r >> 2) + 4 * hi; v[r] = nb < qb ? sc[r] : -INFINITY; }
        float tv[3]; int ti[3];
#pragma unroll
        for (int s3 = 0; s3 < 3; ++s3) { float bv = v[0]; int bi = 4 * hi;
#pragma unroll
            for (int r = 1; r < 16; ++r) { const int nb = (r & 3) + 8 * (r >> 2) + 4 * hi; if (v[r] > bv) { bv = v[r]; bi = nb; } }
            tv[s3] = bv; ti[s3] = bi;
#pragma unroll
            for (int r = 0; r < 16; ++r) { const int nb = (r & 3) + 8 * (r >> 2) + 4 * hi; if (nb == bi) v[r] = -INFINITY; } }
        float pv3[3]; int pi3[3];
#pragma unroll
        for (int s3 = 0; s3 < 3; ++s3) { pv3[s3] = __shfl_xor(tv[s3], 32); pi3[s3] = __shfl_xor(ti[s3], 32); }
        int sel[3]; { int ia = 0, ib = 0;
#pragma unroll
            for (int s3 = 0; s3 < 3; ++s3) { const float va = ia == 0 ? tv[0] : (ia == 1 ? tv[1] : tv[2]), vb = ib == 0 ? pv3[0] : (ib == 1 ? pv3[1] : pv3[2]);
                const int na = ia == 0 ? ti[0] : (ia == 1 ? ti[1] : ti[2]), nb2 = ib == 0 ? pi3[0] : (ib == 1 ? pi3[1] : pi3[2]);
                const bool ta = (va > vb) || (va == vb && na < nb2);
                const float bv = ta ? va : vb; sel[s3] = (bv == -INFINITY) ? -1 : (ta ? na : nb2);
                if (ta) ++ia; else ++ib; } }
        if (hi == 0) {
            const int t = chunk * 32 + r32, p = wid * 32 + r32;
#pragma unroll
            for (int s3 = 0; s3 < 3; ++s3) {
                if (sel[s3] >= 0) { const int rank = __hip_atomic_fetch_add(lcnt + h * NBLK + sel[s3], 1, __ATOMIC_RELAXED, __HIP_MEMORY_SCOPE_WORKGROUP); selb[p * 3 + s3] = (sel[s3] << 16) | rank; }
                else { selb[p * 3 + s3] = -1; LSE[((size_t)t * NH + h) * 4 + s3] = -INFINITY; }
            }
        }
        __syncthreads();
        if (tid < 256) { const int c = lcnt[tid]; if (c > 0) lbase[tid] = (int)atomicAdd(acnt + tid * 64, (unsigned)c); }
        __syncthreads();
        if (tid < 256) { const int hh = tid >> 5, t = chunk * 32 + (tid & 31);
#pragma unroll
            for (int s = 0; s < 3; ++s) { const int v2 = selb[tid * 3 + s]; if (v2 >= 0) { const int bk = hh * NBLK + (v2 >> 16); alist[(size_t)bk * S + lbase[bk] + (v2 & 0xffff)] = t | (s << 16); } } }
        __syncthreads();
    }
    __syncthreads();
    const bf16_t* UB = (const bf16_t*)(a.ws + WS_UB);
    bf16_t* MIX = (bf16_t*)(a.ws + WS_MIXIN);
    const float* cw = a.in[I_CONVW]; const float* cb = a.in[I_CONVB]; const float* lg = a.in[I_CLNG]; const float* lb = a.in[I_CLNB];
    LAS float* red = (LAS float*)(lds + MISC_OFF + 1024);
    const int ch = 2 * tid;
    f32x2 w[CONVW];
#pragma unroll
    for (int j = 0; j < CONVW; ++j) w[j] = *(const f32x2*)(cw + (size_t)j * DC + ch);
    const f32x2 bias = *(const f32x2*)(cb + ch);
    for (int tile = blockIdx.x; tile < S / 16; tile += gridDim.x) {
        const int t0 = tile * 16;
        f32x2 acc[16];
#pragma unroll
        for (int o = 0; o < 16; ++o) acc[o] = bias;
        unsigned uraw[46];
#pragma unroll
        for (int r = 0; r < 46; ++r) { const int t = t0 - 30 + r; uraw[r] = *(const unsigned*)(UB + (size_t)(t >= 0 ? t : 0) * DC + ch); }
        if (t0 < 30) {
#pragma unroll
            for (int r = 0; r < 30; ++r) uraw[r] = (t0 - 30 + r >= 0) ? uraw[r] : 0u;
        }
#pragma unroll
        for (int r = 0; r < 46; ++r) {
            const f32x2 u2 = (f32x2){bf_lo(uraw[r]), bf_hi(uraw[r])};
#pragma unroll
            for (int o = 0; o < 16; ++o) { const int j = r - o; if (j >= 0 && j < CONVW) acc[o] += w[j] * u2; }
        }
        float mean[16];
#define RED16(EXPR, DST) do { float rv[16]; _Pragma("unroll") for (int o = 0; o < 16; ++o) rv[o] = (EXPR); \
        _Pragma("unroll") for (int st = 0; st < 4; ++st) { const int m = 32 >> st, nv = 8 >> st; const bool up = (lane & m) != 0; \
            _Pragma("unroll") for (int v = 0; v < nv; ++v) { const float lo_ = rv[v], hi_ = rv[v + nv]; const float send = up ? lo_ : hi_; const float recv = __shfl_xor(send, m); rv[v] = (up ? hi_ : lo_) + recv; } } \
        float tot = rv[0]; tot += __shfl_xor(tot, 2); tot += __shfl_xor(tot, 1); \
        if ((lane & 3) == 0) (DST)[wid * 16 + (((lane >> 5) & 1) * 8 + ((lane >> 4) & 1) * 4 + ((lane >> 3) & 1) * 2 + ((lane >> 2) & 1))] = tot; } while (0)
        RED16(acc[o][0] + acc[o][1], red);
        __syncthreads();
#pragma unroll
        for (int o = 0; o < 16; ++o) { float s = 0.f;
#pragma unroll
            for (int w8 = 0; w8 < 8; ++w8) s += red[w8 * 16 + o];
            mean[o] = s * (1.f / DC); acc[o] -= mean[o]; }
        RED16(acc[o][0] * acc[o][0] + acc[o][1] * acc[o][1], red + 128);
#undef RED16
        __syncthreads();
        const f32x2 g2 = *(const f32x2*)(lg + ch), b2 = *(const f32x2*)(lb + ch);
#pragma unroll
        for (int o = 0; o < 16; ++o) { float s = 0.f;
#pragma unroll
            for (int w8 = 0; w8 < 8; ++w8) s += red[128 + w8 * 16 + o];
            const float rstd = 1.f / sqrtf(s * (1.f / DC) + LN_EPS);
            const f32x2 y = acc[o] * rstd * g2 + b2;
            const float o0 = y[0] * fast_sigmoid(y[0]), o1 = y[1] * fast_sigmoid(y[1]);
            *(unsigned*)(MIX + (size_t)(t0 + o) * DM + DA + ch) = cvt_pk_bf16(o0, o1); }
        __syncthreads();
    }
}

namespace att {
constexpr int QBLK = 32, KVBLK = 64;
constexpr float SCALE = 0.088388347648318440f;
constexpr int SHM_V = KVBLK * HD * 2, SHM_K = KVBLK * HD * 2;
constexpr int LDQ = DA, LDK = DA;
#define KSWZ(row, colB) ((row) * 256 + ((colB) ^ (((row) & 7) << 4)))
#define SBAR() __builtin_amdgcn_sched_barrier(0)
__device__ __forceinline__ int crow(int r, int hi) { return (r & 3) + 8 * (r >> 2) + 4 * hi; }
__device__ __forceinline__ void bias_mask(f32x16& p0, f32x16& p1, float dist0, float coef, bool MASK) {
#pragma unroll
    for (int r = 0; r < 16; ++r) { const float c = (float)((r & 3) + 8 * (r >> 2)); const float d0 = dist0 - c, d1 = dist0 - c - 32.f;
        p0[r] = fmaf(coef, d0, p0[r]); p1[r] = fmaf(coef, d1, p1[r]);
        if (MASK) { if (d0 < 0.f) p0[r] = -1e30f; if (d1 < 0.f) p1[r] = -1e30f; } }
}
__device__ __forceinline__ void partialSM(f32x16& p0, f32x16& p1, float& m_reg, float& mn, float& alpha) {
    constexpr float C = SCALE * 1.4426950408889634f;
    float pmax = p0[0];
#pragma unroll
    for (int r = 1; r < 16; ++r) pmax = fmaxf(pmax, p0[r]);
#pragma unroll
    for (int r = 0; r < 16; ++r) pmax = fmaxf(pmax, p1[r]);
    { auto rr = __builtin_amdgcn_permlane32_swap(__float_as_uint(pmax), __float_as_uint(pmax), false, false);
      pmax = fmaxf(__uint_as_float(rr[0]), __uint_as_float(rr[1])); }
    mn = fmaxf(m_reg, pmax); alpha = __builtin_amdgcn_exp2f((m_reg - mn) * C); m_reg = mn;
    const float mnC = -mn * C;
#pragma unroll
    for (int r = 0; r < 16; ++r) p0[r] = fmaf(p0[r], C, mnC);
#pragma unroll
    for (int r = 0; r < 16; ++r) p1[r] = fmaf(p1[r], C, mnC);
#pragma unroll
    for (int r = 0; r < 16; ++r) p0[r] = __builtin_amdgcn_exp2f(p0[r]);
}
__device__ __forceinline__ void finishSM(f32x16& p0, f32x16& p1, float alpha, float& l_reg, bf16x8& pa0, bf16x8& pa1, bf16x8& pa2, bf16x8& pa3) {
#pragma unroll
    for (int r = 0; r < 16; ++r) p1[r] = __builtin_amdgcn_exp2f(p1[r]);
    float ps = 0;
#pragma unroll
    for (int r = 0; r < 16; ++r) ps += p0[r];
#pragma unroll
    for (int r = 0; r < 16; ++r) ps += p1[r];
    { auto rr = __builtin_amdgcn_permlane32_swap(__float_as_uint(ps), __float_as_uint(ps), false, false);
      ps = __uint_as_float(rr[0]) + __uint_as_float(rr[1]); }
    l_reg = l_reg * alpha + ps;
#define PK4(P, BASE, OUT) do { unsigned a0 = cvt_pk_bf16(P[BASE + 0], P[BASE + 1]), a1 = cvt_pk_bf16(P[BASE + 2], P[BASE + 3]);   \
    unsigned b0 = cvt_pk_bf16(P[BASE + 4], P[BASE + 5]), b1 = cvt_pk_bf16(P[BASE + 6], P[BASE + 7]);                              \
    auto r0 = __builtin_amdgcn_permlane32_swap(a0, b0, false, false); auto r1 = __builtin_amdgcn_permlane32_swap(a1, b1, false, false); \
    u32x4 w = {r0[0], r1[0], r0[1], r1[1]}; OUT = *reinterpret_cast<bf16x8*>(&w); } while (0)
    PK4(p0, 0, pa0); PK4(p0, 8, pa1); PK4(p1, 0, pa2); PK4(p1, 8, pa3);
#undef PK4
}
__device__ __forceinline__ void qkt(f32x16& p0, f32x16& p1, const char* Ks, const bf16x8* qr, int r32, int hi) {
    p0 = f32x16{}; p1 = f32x16{};
#pragma unroll
    for (int d0 = 0; d0 < 8; ++d0) { const int cb = (d0 * 16 + hi * 8) * 2;
        bf16x8 b0 = *reinterpret_cast<const bf16x8*>(Ks + KSWZ(r32, cb));
        bf16x8 b1 = *reinterpret_cast<const bf16x8*>(Ks + KSWZ(32 + r32, cb));
        p0 = __builtin_amdgcn_mfma_f32_32x32x16_bf16(b0, qr[d0], p0, 0, 0, 0);
        p1 = __builtin_amdgcn_mfma_f32_32x32x16_bf16(b1, qr[d0], p1, 0, 0, 0); }
}
__device__ __forceinline__ int v_st(int k, int c) { const int kk = (k & ~0xC) | ((k & 4) << 1) | ((k & 8) >> 1); return ((kk >> 3) * 4 + (c >> 5)) * 512 + ((kk & 7) * 32 + (c & 31)) * 2; }
__device__ __forceinline__ int v_rd_base(int lane) { return ((lane & 3) << 3) | (((lane >> 2) & 3) << 6) | (((lane >> 4) & 1) << 5) | (((lane >> 5) & 1) << 8); }
constexpr int v_rd_off(int d0, int ks, int half) { return d0 * 512 + ks * 4096 + half * 2048; }
template <int OFF> __device__ __forceinline__ s16x4 tr_read(int vb) {
    s16x4 r; asm volatile("ds_read_b64_tr_b16 %0, %1 offset:%2" : "=&v"(r) : "v"(vb), "i"(OFF) : "memory"); return r;
}
template <int D0> __device__ __forceinline__ void pv_one(f32x16& od, int vb, bf16x8 pa0, bf16x8 pa1, bf16x8 pa2, bf16x8 pa3) {
    const s16x4 l0 = tr_read<v_rd_off(D0, 0, 0)>(vb), h0 = tr_read<v_rd_off(D0, 0, 1)>(vb), l1 = tr_read<v_rd_off(D0, 1, 0)>(vb), h1 = tr_read<v_rd_off(D0, 1, 1)>(vb);
    const s16x4 l2 = tr_read<v_rd_off(D0, 2, 0)>(vb), h2 = tr_read<v_rd_off(D0, 2, 1)>(vb), l3 = tr_read<v_rd_off(D0, 3, 0)>(vb), h3 = tr_read<v_rd_off(D0, 3, 1)>(vb);
    asm volatile("s_waitcnt lgkmcnt(0)" ::: "memory"); SBAR();
#define PK(L, H) (bf16x8){L[0], L[1], L[2], L[3], H[0], H[1], H[2], H[3]}
    od = __builtin_amdgcn_mfma_f32_32x32x16_bf16(pa0, PK(l0, h0), od, 0, 0, 0);
    od = __builtin_amdgcn_mfma_f32_32x32x16_bf16(pa1, PK(l1, h1), od, 0, 0, 0);
    od = __builtin_amdgcn_mfma_f32_32x32x16_bf16(pa2, PK(l2, h2), od, 0, 0, 0);
    od = __builtin_amdgcn_mfma_f32_32x32x16_bf16(pa3, PK(l3, h3), od, 0, 0, 0);
#undef PK
}
__device__ __forceinline__ void pv_d0(f32x16* o, int vb, bf16x8 pa0, bf16x8 pa1, bf16x8 pa2, bf16x8 pa3) {
    pv_one<0>(o[0], vb, pa0, pa1, pa2, pa3); pv_one<1>(o[1], vb, pa0, pa1, pa2, pa3); pv_one<2>(o[2], vb, pa0, pa1, pa2, pa3); pv_one<3>(o[3], vb, pa0, pa1, pa2, pa3);
}
__device__ __forceinline__ void attn_group(const bf16_t* __restrict__ QB, int trow, int dst, int h, int kblk, bool mask, int ntl,
                                           bf16_t* __restrict__ OP, float* __restrict__ LSEp, const char* K_lds, const char* V_lds, float* ws) {
    const int lane = threadIdx.x & 63, r32 = lane & 31, hi = lane >> 5;
    float* li_l = ws; float* al_l = ws + 32; int* dst_l = (int*)(ws + 64);
    if (hi == 0) dst_l[r32] = dst;
    float m_reg = -1e30f, l_reg = 0; f32x16 o[4] = {}; bf16x8 qr[8];
    const bf16_t* Qw = QB + (size_t)trow * LDQ + h * HD + hi * 8;
#pragma unroll
    for (int d0 = 0; d0 < 8; ++d0) qr[d0] = *reinterpret_cast<const bf16x8*>(Qw + d0 * 16);
    const float slope = __builtin_amdgcn_exp2f(-(float)(h + 1)), coef = -slope / SCALE;
    float distb = (float)(trow - kblk * BLK - 4 * hi);
    int vb = (int)(uintptr_t)V_lds + v_rd_base(lane);
#define RESC(a) do { if (__any((a) < 1.f)) { if (hi == 0) al_l[r32] = (a); asm volatile("s_waitcnt lgkmcnt(0)" ::: "memory"); \
    _Pragma("unroll") for (int d = 0; d < 4; ++d) _Pragma("unroll") for (int r = 0; r < 16; ++r) o[d][r] *= al_l[crow(r, hi)]; } } while (0)
    if (ntl == 4) {
        f32x16 pA0, pA1, pB0, pB1; float mnA, mnB, alA, alB; bf16x8 pa0, pa1, pa2, pa3;
        qkt(pA0, pA1, K_lds, qr, r32, hi); bias_mask(pA0, pA1, distb, coef, mask); partialSM(pA0, pA1, m_reg, mnA, alA);
        SBAR(); qkt(pB0, pB1, K_lds + SHM_K, qr, r32, hi); bias_mask(pB0, pB1, distb - 64.f, coef, mask);
        finishSM(pA0, pA1, alA, l_reg, pa0, pa1, pa2, pa3); SBAR();
        pv_d0(o, vb, pa0, pa1, pa2, pa3); partialSM(pB0, pB1, m_reg, mnB, alB);
        RESC(alB);
        SBAR(); qkt(pA0, pA1, K_lds + 2 * SHM_K, qr, r32, hi); bias_mask(pA0, pA1, distb - 128.f, coef, mask);
        finishSM(pB0, pB1, alB, l_reg, pa0, pa1, pa2, pa3); SBAR();
        pv_d0(o, vb + SHM_V, pa0, pa1, pa2, pa3); partialSM(pA0, pA1, m_reg, mnA, alA);
        RESC(alA);
        SBAR(); qkt(pB0, pB1, K_lds + 3 * SHM_K, qr, r32, hi); bias_mask(pB0, pB1, distb - 192.f, coef, mask);
        finishSM(pA0, pA1, alA, l_reg, pa0, pa1, pa2, pa3); SBAR();
        pv_d0(o, vb + 2 * SHM_V, pa0, pa1, pa2, pa3); partialSM(pB0, pB1, m_reg, mnB, alB);
        RESC(alB);
        finishSM(pB0, pB1, alB, l_reg, pa0, pa1, pa2, pa3); SBAR();
        pv_d0(o, vb + 3 * SHM_V, pa0, pa1, pa2, pa3);
    } else {
        for (int tl = 0; tl < ntl; ++tl) {
            f32x16 p0, p1; float mn, al; bf16x8 pa0, pa1, pa2, pa3;
            qkt(p0, p1, K_lds + tl * SHM_K, qr, r32, hi); bias_mask(p0, p1, distb, coef, mask);
            partialSM(p0, p1, m_reg, mn, al);
            RESC(al);
            finishSM(p0, p1, al, l_reg, pa0, pa1, pa2, pa3); SBAR();
            pv_d0(o, vb, pa0, pa1, pa2, pa3);
            distb -= 64.f; vb += SHM_V;
        }
    }
#undef RESC
    if (hi == 0) { li_l[r32] = l_reg; if (dst >= 0) LSEp[dst] = m_reg * (SCALE * 1.4426950408889634f) + __builtin_amdgcn_logf(l_reg); }
    asm volatile("s_waitcnt lgkmcnt(0)" ::: "memory");
#pragma unroll
    for (int rp = 0; rp < 8; ++rp) {
        const int ra = 2 * rp, rb = 2 * rp + 1; const int rowa = crow(ra, hi), rowb = crow(rb, hi);
        const float ia = __builtin_amdgcn_rcpf(li_l[rowa]), ib = __builtin_amdgcn_rcpf(li_l[rowb]);
        const int da = dst_l[rowa], db = dst_l[rowb];
        const bool odd = lane & 1;
        const int dd = odd ? db : da;
        bf16_t* orow = OP + (size_t)(dd < 0 ? 0 : dd) * HD + (r32 & ~1);
#pragma unroll
        for (int d0 = 0; d0 < 4; ++d0) { const float va = o[d0][ra] * ia, vb2 = o[d0][rb] * ib;
            const float send = odd ? va : vb2; const float recv = __shfl_xor(send, 1);
            const unsigned w = odd ? cvt_pk_bf16(recv, vb2) : cvt_pk_bf16(va, recv);
            if (dd >= 0) *(unsigned*)(orow + d0 * 32) = w; }
    }
}
}

__device__ __forceinline__ void phase_attention(const Args& a, LAS unsigned char* ldsl, char* lds, bool second) {
    const int tid = threadIdx.x, wid = tid >> 6, lane = tid & 63, r32 = lane & 31;
    const bf16_t* QB = (const bf16_t*)(a.ws + WS_QB); const bf16_t* KB = (const bf16_t*)(a.ws + WS_KB); const bf16_t* VB = (const bf16_t*)(a.ws + WS_VB);
    const unsigned* acnt = (const unsigned*)(a.ws + WS_CTL) + CW_ACNT;
    unsigned* aq = (unsigned*)(a.ws + WS_CTL) + (second ? CW_AQ + 64 : CW_AQ);
    const int* alist = (const int*)(a.ws + WS_ALIST);
    bf16_t* OP = (bf16_t*)(a.ws + WS_OPART); float* LSE = (float*)(a.ws + WS_LSE);
    volatile LAS int* pfx = (volatile LAS int*)(ldsl + MISC_OFF + 2048);
    char* K_lds = lds; char* V_lds = lds + 65536;
    float* wsc = (float*)(lds + MISC_OFF + 4096) + wid * 128;
    if (tid < 256) { const int ng = (int)((acnt[tid * 64] + 31u) >> 5); int v = (ng + 15) >> 4;
#pragma unroll
        for (int o = 1; o < 64; o <<= 1) { const int t = __shfl_up(v, o); if (lane >= o) v += t; }
        pfx[1 + tid] = v; if (lane == 63) pfx[300 + wid] = v; }
    __syncthreads();
    if (tid < 256) { int add = 0; for (int w = 0; w < wid; ++w) add += pfx[300 + w]; pfx[1 + tid] += add; if (tid == 0) pfx[0] = 0; }
    if (tid == 0) pfx[310] = (int)atomicAdd(aq, 1u);
    __syncthreads();
    const int nsel = pfx[256], nitems = 256 + nsel;
    for (;;) {
        const int it = pfx[310];
        __syncthreads();
        if (it >= nitems) break;
        if (tid == 0) pfx[310] = (int)atomicAdd(aq, 1u);
        int h, kb, g0, g1, b = 0; bool mask;
        if (it < nsel) {
#pragma unroll
            for (int s = 128; s >= 1; s >>= 1) { if (pfx[b + s] <= it) b += s; }
            b = __builtin_amdgcn_readfirstlane(b);
            const int k = __builtin_amdgcn_readfirstlane(it - pfx[b]); h = b >> 5; kb = b & 31; mask = false;
            const int ng = (int)((acnt[b * 64] + 31u) >> 5); g0 = 16 * k; g1 = (g0 + 16 < ng) ? g0 + 16 : ng;
        } else { const int j = it - nsel; h = j >> 5; kb = j & 31; mask = true; g0 = 0; g1 = 8; }
        { const bf16_t* Kh = KB + (size_t)kb * BLK * DA + h * HD; const bf16_t* Vh = VB + (size_t)kb * BLK * DA + h * HD;
          const int sr = tid >> 4, sc = (tid & 15) * 8;
          bf16x8 kv[8], vv[8];
#pragma unroll
          for (int j = 0; j < 8; ++j) { kv[j] = *(const bf16x8*)(Kh + (size_t)(sr + 32 * j) * DA + sc); vv[j] = *(const bf16x8*)(Vh + (size_t)(sr + 32 * j) * DA + sc); }
#pragma unroll
          for (int j = 0; j < 8; ++j) { const int row = sr + 32 * j, tl = row >> 6, rr = row & 63;
              *(bf16x8*)(K_lds + tl * att::SHM_K + KSWZ(rr, sc * 2)) = kv[j]; *(bf16x8*)(V_lds + tl * att::SHM_V + att::v_st(rr, sc)) = vv[j]; } }
        __syncthreads();
        const int cnt = mask ? 0 : (int)acnt[b * 64];
        for (int g = g0 + wid; g < g1; g += 8) {
            int trow, dst, ntl = 4;
            if (mask) { trow = kb * BLK + g * 32 + r32; dst = (trow * NH + h) * 4 + 3; ntl = (g >> 1) + 1; }
            else { const int ei = g * 32 + r32; const bool valid = ei < cnt; const int ent = alist[(size_t)b * S + (valid ? ei : 0)];
                trow = ent & 0xffff; dst = valid ? (trow * NH + h) * 4 + (ent >> 16) : -1; }
            att::attn_group(QB, trow, dst, h, kb, mask, ntl, OP, LSE, K_lds, V_lds, wsc);
        }
    }
}

__device__ __forceinline__ void phase_attn_combine(const Args& a) {
    const int tid = threadIdx.x, wid = tid >> 6, lane = tid & 63;
    const bf16_t* OP = (const bf16_t*)(a.ws + WS_OPART); const float* LSE = (const float*)(a.ws + WS_LSE); bf16_t* MIX = (bf16_t*)(a.ws + WS_MIXIN);
    const int gw = blockIdx.x * NWAVES + wid, ngw = gridDim.x * NWAVES;
    constexpr int U = 4;
    for (int p0 = gw * U; p0 < S * NH; p0 += ngw * U) {
        f32x4 l[U]; unsigned v[U][4];
#pragma unroll
        for (int u = 0; u < U; ++u) l[u] = *(const f32x4*)(LSE + (size_t)(p0 + u) * 4);
#pragma unroll
        for (int u = 0; u < U; ++u)
#pragma unroll
            for (int s = 0; s < 4; ++s) v[u][s] = (l[u][s] > -INFINITY) ? *(const unsigned*)(OP + ((size_t)(p0 + u) * 4 + s) * HD + 2 * lane) : 0u;
#pragma unroll
        for (int u = 0; u < U; ++u) {
            const float M = fmaxf(fmaxf(l[u][0], l[u][1]), fmaxf(l[u][2], l[u][3]));
            float ws = 0.f, o0 = 0.f, o1 = 0.f;
#pragma unroll
            for (int s = 0; s < 4; ++s) { const float wgt = __builtin_amdgcn_exp2f(l[u][s] - M); ws += wgt; o0 += wgt * bf_lo(v[u][s]); o1 += wgt * bf_hi(v[u][s]); }
            const float inv = 1.f / ws;
            const int p = p0 + u, t = p >> 3, h = p & 7;
            *(unsigned*)(MIX + (size_t)t * DM + h * HD + 2 * lane) = cvt_pk_bf16(o0 * inv, o1 * inv);
        }
    }
}

__device__ __forceinline__ void phase_ln1_router(const Args& a, LAS unsigned char* lds, bool dry) {
    const int tid = threadIdx.x, wid = __builtin_amdgcn_readfirstlane(tid >> 6), lane = tid & 63;
    const bf16_t* H = (const bf16_t*)(a.ws + WS_H1);
    const float* g1 = a.in[I_LN1G]; const float* b1 = a.in[I_LN1B]; const float* br = a.in[I_BR];
    unsigned* ecnt = (unsigned*)(a.ws + WS_CTL) + (dry ? CW_ECNT2 : CW_ECNT);
    int* tokrow = (int*)(a.ws + (dry ? WS_QB : WS_TOKROW)); float* gatel = (float*)(a.ws + (dry ? WS_KB : WS_GATE)); int* toklist = (int*)(a.ws + (dry ? WS_VB : WS_TOKLIST)); bf16_t* HB = (bf16_t*)(a.ws + (dry ? WS_MIXIN : WS_H1B)); unsigned char* H8 = a.ws + (dry ? WS_UB : WS_H8);
    const bf16_t* wimg = (const bf16_t*)(a.ws + WS_WRT);
    LAS int* ecl = (LAS int*)(lds + MISC_OFF + 4096);
    LAS int* ebase = ecl + 32;
    LAS int* rinfo = ebase + 32;
    LAS float* rgate = (LAS float*)(rinfo + 128);
    for (int rb = blockIdx.x * 2; rb < S / 16; rb += gridDim.x * 2) {
      if (tid < 32) ecl[tid] = 0;
      for (int pass = 0; pass < 2; ++pass) {
        asm volatile("" : "+s"(g1), "+s"(b1), "+s"(wimg), "+s"(H), "+s"(HB), "+s"(H8));
        const int row0 = (rb + pass) * 16 + wid * 2;
        __syncthreads();
#pragma unroll
        for (int r = 0; r < 2; ++r) {
            const bf16_t* hp = H + (size_t)(row0 + r) * DM;
            f32x4 hv[4][2]; float s = 0.f;
#pragma unroll
            for (int j = 0; j < 4; ++j) { const u32x4 hw = *(const u32x4*)(hp + (64 * j + lane) * 8);
                hv[j][0] = (f32x4){bf_lo(hw.x), bf_hi(hw.x), bf_lo(hw.y), bf_hi(hw.y)}; hv[j][1] = (f32x4){bf_lo(hw.z), bf_hi(hw.z), bf_lo(hw.w), bf_hi(hw.w)};
#pragma unroll
                for (int hh = 0; hh < 2; ++hh) s += (hv[j][hh][0] + hv[j][hh][1]) + (hv[j][hh][2] + hv[j][hh][3]); }
            const float mean = wave_sum(s) * (1.f / DM); float s2 = 0.f;
#pragma unroll
            for (int j = 0; j < 4; ++j)
#pragma unroll
                for (int hh = 0; hh < 2; ++hh) { hv[j][hh] -= mean; const f32x4 d = hv[j][hh]; s2 += (d[0] * d[0] + d[1] * d[1]) + (d[2] * d[2] + d[3] * d[3]); }
            const float rstd = 1.f / sqrtf(wave_sum(s2) * (1.f / DM) + LN_EPS);
            bf16_t* hb = HB + (size_t)(row0 + r) * DM;
            const int lr = wid * 2 + r;
#pragma unroll
            for (int j = 0; j < 4; ++j) {
#pragma unroll
                for (int hh = 0; hh < 2; ++hh) { const int k = (64 * j + lane) * 8 + 4 * hh; const f32x4 gg = *(const f32x4*)(g1 + k), bb = *(const f32x4*)(b1 + k);
                    hv[j][hh] = hv[j][hh] * rstd * gg + bb; }
                const f32x4 x0 = hv[j][0], x1 = hv[j][1];
                u32x4 w; w.x = cvt_pk_bf16(x0[0], x0[1]); w.y = cvt_pk_bf16(x0[2], x0[3]); w.z = cvt_pk_bf16(x1[0], x1[1]); w.w = cvt_pk_bf16(x1[2], x1[3]);
                *(u32x4*)(hb + (64 * j + lane) * 8) = w;
                u32x2 w8; w8.x = cvt4_fp8(x0[0] * SC_H, x0[1] * SC_H, x0[2] * SC_H, x0[3] * SC_H); w8.y = cvt4_fp8(x1[0] * SC_H, x1[1] * SC_H, x1[2] * SC_H, x1[3] * SC_H);
                *(u32x2*)(H8 + (size_t)(row0 + r) * DM + (64 * j + lane) * 8) = w8;
                u32x4 wl; wl.x = cvt_pk_bf16(x0[0] - bf_lo(w.x), x0[1] - bf_hi(w.x)); wl.y = cvt_pk_bf16(x0[2] - bf_lo(w.y), x0[3] - bf_hi(w.y));
                wl.z = cvt_pk_bf16(x1[0] - bf_lo(w.z), x1[1] - bf_hi(w.z)); wl.w = cvt_pk_bf16(x1[2] - bf_lo(w.w), x1[3] - bf_hi(w.w));
                const int off = lr * 4096 + (((64 * j + lane) ^ (lr & 15)) * 16);
                *(LAS u32x4*)(lds + off) = w; *(LAS u32x4*)(lds + 65536 + off) = wl;
                asm volatile("" ::: "memory"); }
        }
        __syncthreads();
        f32x4 lg0 = (f32x4){0.f, 0.f, 0.f, 0.f}, lg1 = lg0;
        { const int arow = lane & 15, kq = lane >> 4;
#pragma unroll
          for (int si = 0; si < 8; ++si) { const int ss = wid * 8 + si;
              const int aoff = arow * 4096 + (((4 * ss + kq) ^ arow) * 16);
              const bf16x8 ah = *(const LAS bf16x8*)(lds + aoff), al = *(const LAS bf16x8*)(lds + 65536 + aoff);
              const bf16_t* wp = wimg + ((size_t)(ss * 2) * 64 + lane) * 8;
              const bf16x8 bh0 = *(const bf16x8*)wp, bh1 = *(const bf16x8*)(wp + 512), bl0 = *(const bf16x8*)(wp + DM * NE), bl1 = *(const bf16x8*)(wp + DM * NE + 512);
              lg0 = __builtin_amdgcn_mfma_f32_16x16x32_bf16(ah, bh0, lg0, 0, 0, 0); lg0 = __builtin_amdgcn_mfma_f32_16x16x32_bf16(ah, bl0, lg0, 0, 0, 0); lg0 = __builtin_amdgcn_mfma_f32_16x16x32_bf16(al, bh0, lg0, 0, 0, 0);
              lg1 = __builtin_amdgcn_mfma_f32_16x16x32_bf16(ah, bh1, lg1, 0, 0, 0); lg1 = __builtin_amdgcn_mfma_f32_16x16x32_bf16(ah, bl1, lg1, 0, 0, 0); lg1 = __builtin_amdgcn_mfma_f32_16x16x32_bf16(al, bh1, lg1, 0, 0, 0); } }
        __syncthreads();
        { LAS float* part = (LAS float*)lds + wid * 512;
#pragma unroll
          for (int q = 0; q < 4; ++q) { const int prow = 4 * (lane >> 4) + q; part[prow * 32 + (lane & 15)] = lg0[q]; part[prow * 32 + 16 + (lane & 15)] = lg1[q]; } }
        __syncthreads();
        const int e = lane & 31, rr = lane >> 5;
        float lg = br[e];
#pragma unroll
        for (int w8 = 0; w8 < 8; ++w8) lg += ((const LAS float*)lds)[w8 * 512 + (wid * 2 + rr) * 32 + e];
        int sel_e[4]; float sel_v[4]; float gcur = lg;
#pragma unroll
        for (int s = 0; s < 4; ++s) { float bv = gcur; int bi = e;
#pragma unroll
            for (int o = 1; o < 32; o <<= 1) { const float ov = __shfl_xor(bv, o, 32); const int oi = __shfl_xor(bi, o, 32); if (ov > bv || (ov == bv && oi < bi)) { bv = ov; bi = oi; } }
            sel_e[s] = bi; sel_v[s] = bv; if (e == bi) gcur = -INFINITY; }
        float ex[4], es = 0.f;
#pragma unroll
        for (int s = 0; s < 4; ++s) { ex[s] = __expf(sel_v[s] - sel_v[0]); es += ex[s]; }
        const float einv = 1.f / es;
        const int lrow = pass * 16 + wid * 2 + rr;
#pragma unroll
        for (int s = 0; s < 4; ++s) { if (e == sel_e[s]) { const int rank = __hip_atomic_fetch_add(ecl + e, 1, __ATOMIC_RELAXED, __HIP_MEMORY_SCOPE_WORKGROUP);
            rinfo[lrow * 4 + s] = (e << 16) | rank; rgate[lrow * 4 + s] = ex[s] * einv; } }
      }
      VM_WAIT(); __syncthreads();
      if (tid < 32) { const int c = ecl[tid]; ebase[tid] = c > 0 ? (int)atomicAdd(ecnt + tid * 64, (unsigned)c) : 0; }
      __syncthreads();
      if (tid < 128) { const int cidx = tid, lrow = cidx >> 2; const int info = rinfo[cidx]; const int e = info >> 16;
          const int drow = e * ECAP + ebase[e] + (info & 0xffff); const int t = rb * 16 + lrow;
          gatel[drow] = rgate[cidx]; toklist[drow] = t; tokrow[(size_t)t * 4 + (cidx & 3)] = drow; }
      __syncthreads();
    }
}

__device__ __forceinline__ void phase_final(const Args& a) {
    const int tid = threadIdx.x, wid = tid >> 6, lane = tid & 63;
    const bf16_t* HB = (const bf16_t*)(a.ws + WS_H1B); const unsigned char* Y = a.ws + WS_XG; const int* tokrow = (const int*)(a.ws + WS_TOKROW);
    const float* g2 = a.in[I_LN2G]; const float* b2 = a.in[I_LN2B]; float* out = a.out;
    const int gw = blockIdx.x * NWAVES + wid, ngw = gridDim.x * NWAVES;
    typedef int i32x4 __attribute__((ext_vector_type(4)));
    constexpr int U = 2;
    for (int t0 = gw * U; t0 < S; t0 += ngw * U) {
        asm volatile("" : "+s"(g2), "+s"(b2), "+s"(out), "+s"(HB), "+s"(Y));
        i32x4 tr[U];
#pragma unroll
        for (int u = 0; u < U; ++u) tr[u] = *(const i32x4*)(tokrow + (size_t)(t0 + u) * 4);
        u32x4 hb[U][4]; u32x2 yr[U][4][4];
#pragma unroll
        for (int u = 0; u < U; ++u)
#pragma unroll
            for (int j = 0; j < 4; ++j) { const int k = (64 * j + lane) * 8; hb[u][j] = *(const u32x4*)(HB + (size_t)(t0 + u) * DM + k);
#pragma unroll
                for (int s = 0; s < 4; ++s) yr[u][j][s] = *(const u32x2*)(Y + (size_t)tr[u][s] * DM + k); }
#pragma unroll
        for (int u = 0; u < U; ++u) {
            const int t = t0 + u;
            f32x4 v[4][2]; float sm = 0.f;
#pragma unroll
            for (int j = 0; j < 4; ++j) { const u32x4 h4 = hb[u][j];
                f32x4 x0 = (f32x4){bf_lo(h4.x), bf_hi(h4.x), bf_lo(h4.y), bf_hi(h4.y)} * DN_ALPHA, x1 = (f32x4){bf_lo(h4.z), bf_hi(h4.z), bf_lo(h4.w), bf_hi(h4.w)} * DN_ALPHA;
#pragma unroll
                for (int s = 0; s < 4; ++s) { const u32x2 y = yr[u][j][s]; constexpr float iy = 1.f / SC_Y;
                    const f32x2 a0 = __builtin_amdgcn_cvt_pk_f32_fp8((int)y.x, false), a1 = __builtin_amdgcn_cvt_pk_f32_fp8((int)y.x, true), a2 = __builtin_amdgcn_cvt_pk_f32_fp8((int)y.y, false), a3 = __builtin_amdgcn_cvt_pk_f32_fp8((int)y.y, true);
                    x0[0] += a0[0] * iy; x0[1] += a0[1] * iy; x0[2] += a1[0] * iy; x0[3] += a1[1] * iy; x1[0] += a2[0] * iy; x1[1] += a2[1] * iy; x1[2] += a3[0] * iy; x1[3] += a3[1] * iy; }
                v[j][0] = x0; v[j][1] = x1; sm += (x0[0] + x0[1]) + (x0[2] + x0[3]) + (x1[0] + x1[1]) + (x1[2] + x1[3]); }
            const float mean = wave_sum(sm) * (1.f / DM); float s2 = 0.f;
#pragma unroll
            for (int j = 0; j < 4; ++j)
#pragma unroll
                for (int hh = 0; hh < 2; ++hh) { v[j][hh] -= mean; const f32x4 d = v[j][hh]; s2 += (d[0] * d[0] + d[1] * d[1]) + (d[2] * d[2] + d[3] * d[3]); }
            const float rstd = 1.f / sqrtf(wave_sum(s2) * (1.f / DM) + LN_EPS);
#pragma unroll
            for (int j = 0; j < 4; ++j)
#pragma unroll
                for (int hh = 0; hh < 2; ++hh) { const int k = (64 * j + lane) * 8 + 4 * hh; const f32x4 gg = *(const f32x4*)(g2 + k), bb = *(const f32x4*)(b2 + k);
                    *(f32x4*)(out + (size_t)t * DM + k) = v[j][hh] * rstd * gg + bb; }
        }
    }
}

__global__ void __launch_bounds__(NTHR, 2) hybrid_fwd(Args args) {
    extern __shared__ __attribute__((aligned(16))) unsigned char lds_raw[];
    LAS unsigned char* lds = (LAS unsigned char*)lds_raw;
    volatile LAS unsigned* MISC = (volatile LAS unsigned*)(lds + MISC_OFF);
    const int tid = threadIdx.x;
    if (tid < 64) MISC[tid] = 0u;
    __syncthreads();
    unsigned char* ws = args.ws;
    const int lo = args.ph_lo, hi = args.ph_hi;
    XcdBarrier bar; bar.bar = (unsigned*)(ws + WS_CTL) + CW_BAR; bar.x = 0; bar.st = nullptr;
    if (hi - lo > 1) bar = xcd_barrier_post((unsigned*)(ws + WS_CTL) + CW_BAR, MISC + 8);
#ifndef PH_MASK
#define PH_MASK 0x3ff
#endif
#define IN(k) (((PH_MASK >> (k)) & 1) && lo <= (k) && (k) < hi)
    volatile LAS int* cqb = (volatile LAS int*)(lds + MISC_OFF + 256);
#define SEAM(k) do { if (IN(k) && IN((k) + 1)) { if ((k) == 1) { cq_while_waiting(args, lds, cqb, (unsigned)gridDim.x, CQ_N); cq_drain(args, lds, cqb, CQ_N); } xcd_barrier(bar); } } while (0)

#ifndef PH_REPEAT
#define PH_REPEAT 0
#endif
#define REP(k) ((PH_REPEAT >> (k)) & 1)
#define RUN(k, ...) do { if (IN(k)) { __VA_ARGS__; if (REP(k)) { xcd_barrier(bar); __VA_ARGS__; } } } while (0)
    RUN(0, phase_convert(args, lds));
    SEAM(0);
    RUN(1, {
        { const int r = (int)(blockIdx.x >> 3) - (32 - CV_P1_WGS / 8);
          if (r >= 0) { constexpr int per = CV_P1 / CV_P1_WGS; const int k = r * 8 + (int)(blockIdx.x & 7); moe_convert_items(args, lds, k * per, per); __syncthreads(); } }
        pg8::DenseOrder So; So.init(S, INCOLS, gridDim.x, blockIdx.x, ws + WS_XB, ws + WS_WINT); So.q = (unsigned*)(ws + WS_CTL) + CW_GQ;
        pg8::EpiInProj E{(bf16_t*)(ws + WS_QB), (bf16_t*)(ws + WS_UB), (float*)(ws + WS_CTL + CTL_KSUM)};
        pg8::gemm_phase<pg8::EpiInProj, pg8::DenseOrder>(lds, So, E, (LAS int*)(lds + MISC_OFF + 4096));
    });
    SEAM(1);
    if (IN(2)) { phase_gate_conv(args, lds, false); if (REP(2)) { xcd_barrier(bar); phase_gate_conv(args, lds, true); } }
    SEAM(2);
    if (IN(3)) {
        { const int r = (int)(blockIdx.x >> 3) - (32 - CV_P3_WGS / 8);
          if (r >= 0) { constexpr int per = (TI_GU - CV_P1) / CV_P3_WGS; const int k = r * 8 + (int)(blockIdx.x & 7);
              { f32x4 vw[8]; for (int it = TI_WIN + k; it < TI_WIN + TI_WOUT; it += CV_P3_WGS) { const TItem ia = t_decode(args, it); t_load(ia, vw, tid); t_process(ia, vw, lds, tid); } }
              moe_convert_items(args, lds, CV_P1 + k * per, per); __syncthreads(); } }
        phase_attention(args, lds, (char*)lds_raw, false); if (REP(3)) { xcd_barrier(bar); phase_attention(args, lds, (char*)lds_raw, true); } }
    SEAM(3);
    RUN(4, phase_attn_combine(args));
    SEAM(4);
    RUN(5, {
        pg8::DenseOrder So; So.init(S, DM, gridDim.x, blockIdx.x, ws + WS_MIXIN, ws + WS_WOUTT); So.q = nullptr;
        pg8::EpiOutProj E{(const bf16_t*)(ws + WS_XB), (bf16_t*)(ws + WS_H1)};
        pg8::gemm_phase<pg8::EpiOutProj, pg8::DenseOrder>(lds, So, E, (LAS int*)(lds + MISC_OFF + 4096));
    });
    SEAM(5);
    if (IN(6)) { phase_ln1_router(args, lds, false); if (REP(6)) { xcd_barrier(bar); phase_ln1_router(args, lds, true); } }
    SEAM(6);
    if (IN(7) || IN(8)) {
        volatile LAS int* pfx = (volatile LAS int*)(lds + MISC_OFF + 512);
        if (tid < 64) { const unsigned* ecnt = (const unsigned*)(ws + WS_CTL) + CW_ECNT; int v = (tid < NE) ? (int)((ecnt[(tid & 31) * 64] + 255u) >> 8) : 0;
#pragma unroll
            for (int o = 1; o < 64; o <<= 1) { const int t = __shfl_up(v, o); if ((tid & 63) >= o) v += t; }
            if (tid < NE) { pfx[1 + tid] = v; pfx[40 + tid] = (int)ecnt[tid * 64]; } if (tid == 0) pfx[0] = 0; }
        __syncthreads();
        RUN(7, {
            { const int r = (int)(blockIdx.x >> 3) - (32 - CV_P7_WGS / 8);
              if (r >= 0) { constexpr int per = (TI_D + CV_P7_WGS - 1) / CV_P7_WGS; const int k = r * 8 + (int)(blockIdx.x & 7); const int f = k * per; const int n = (f + per <= TI_D) ? per : (TI_D > f ? TI_D - f : 0);
                  moe_convert_items(args, lds, TI_GU + f, n); __syncthreads(); } }
            pg8::MoeOrder So{pfx, 16, (int)gridDim.x, (int)blockIdx.x, (const char*)(ws + WS_H8), (const char*)(ws + WS_WGUT), 0, (size_t)4096 * 2048, (size_t)256 * 2048, (const int*)(ws + WS_TOKLIST), (unsigned)S, (unsigned*)(ws + WS_CTL) + CW_GQ + 16 * 64};
            pg8::EpiGateUp E{ws + WS_ACT, args.in[I_BGU]};
            pg8::gemm_phase<pg8::EpiGateUp, pg8::MoeOrder, true, true>(lds, So, E, (LAS int*)(lds + MISC_OFF + 4096));
        });
        SEAM(7);
        RUN(8, {
            pg8::MoeOrder So{pfx, 8, (int)gridDim.x, (int)blockIdx.x, (const char*)(ws + WS_ACT), (const char*)(ws + WS_WDT), 0, (size_t)2048 * 2048, (size_t)256 * 2048, (const int*)(ws + WS_IDLIST), (unsigned)(NE * ECAP), nullptr};
            pg8::EpiDown E{ws + WS_XG, args.in[I_BD], (const float*)(ws + WS_GATE)};
            pg8::gemm_phase<pg8::EpiDown, pg8::MoeOrder, true, true>(lds, So, E, (LAS int*)(lds + MISC_OFF + 4096));
        });
    }
    SEAM(8);
    RUN(9, phase_final(args));
#undef IN
#undef SEAM
}

extern "C" void kernel_launch(void* const* d_in, const int* in_sizes, int n_in, void* d_out, int out_size, void* d_ws, size_t ws_size, hipStream_t stream) {
    static int grid = 0;
    if (grid == 0) {
        if (n_in != 17 || in_sizes[0] != S * DM || out_size != S * DM || ws_size < WS_END) {
            fprintf(stderr, "kernel_launch: built for 17 inputs, x/out of %d floats, >= %zu bytes of workspace; got n_in %d, in0 %d, out %d, ws %zu; nothing launched\n", S * DM, (size_t)WS_END, n_in, n_in > 0 ? in_sizes[0] : -1, out_size, ws_size);
            grid = -1; return; }
        int dev = 0, cus = 0, per_cu = 0;
        if (hipGetDevice(&dev) != hipSuccess || hipDeviceGetAttribute(&cus, hipDeviceAttributeMultiprocessorCount, dev) != hipSuccess) { fprintf(stderr, "kernel_launch: device query failed\n"); grid = -1; return; }
        if (hipFuncSetAttribute((const void*)hybrid_fwd, hipFuncAttributeMaxDynamicSharedMemorySize, LDS_BYTES) != hipSuccess) { fprintf(stderr, "kernel_launch: hipFuncSetAttribute failed\n"); grid = -1; return; }
        if (hipOccupancyMaxActiveBlocksPerMultiprocessor(&per_cu, (const void*)hybrid_fwd, NTHR, LDS_BYTES) != hipSuccess || per_cu < 1)
            fprintf(stderr, "kernel_launch: note: occupancy query reports %d workgroups per CU\n", per_cu);
        (void)hipGetLastError();
        grid = cus;
    }
    if (grid < 0) return;
    if (hipMemsetAsync((char*)d_ws + WS_CTL, 0, CTL_ZERO_BYTES, stream) != hipSuccess) { fprintf(stderr, "kernel_launch: memset failed\n"); return; }
    Args a{};
    for (int i = 0; i < 17; ++i) a.in[i] = (const float*)d_in[i];
    a.out = (float*)d_out; a.ws = (unsigned char*)d_ws;
#if MK_N_LAUNCHES == 1
    a.ph_lo = 0; a.ph_hi = NPHASE;
    hipLaunchKernelGGL(hybrid_fwd, dim3(grid), dim3(NTHR), LDS_BYTES, stream, a);
#else
    for (int p = 0; p < NPHASE; ++p) { a.ph_lo = p; a.ph_hi = p + 1; hipLaunchKernelGGL(hybrid_fwd, dim3(grid), dim3(NTHR), LDS_BYTES, stream, a); }
#endif
    const hipError_t le = hipPeekAtLastError();
    if (le != hipSuccess) fprintf(stderr, "kernel_launch: launch failed: %s\n", hipGetErrorName(le));
}
```

```cpp
#include <hip/hip_runtime.h>
#include <cstdio>
#include <cstdint>

#ifndef MK_N_LAUNCHES
#define MK_N_LAUNCHES 1
#endif

#define GAS __attribute__((address_space(1)))
#define LAS __attribute__((address_space(3)))
typedef unsigned short bf16_t;
typedef short bf16x8 __attribute__((ext_vector_type(8)));
typedef short s16x4 __attribute__((ext_vector_type(4)));
typedef float f32x4 __attribute__((ext_vector_type(4)));
typedef float f32x2 __attribute__((ext_vector_type(2)));
typedef float f32x16 __attribute__((ext_vector_type(16)));
typedef unsigned u32x4 __attribute__((ext_vector_type(4)));
typedef unsigned u32x2 __attribute__((ext_vector_type(2)));

constexpr int S = 8192, DM = 2048, DA = 1024, DC = 1024, NH = 8, HD = 128, NBLK = 32, BLK = 256;
constexpr int NE = 32, DFF = 2048, INCOLS = 5120, CONVW = 31;
constexpr int ECAP = 8192;
constexpr float LN_EPS = 1e-5f;
constexpr float DN_ALPHA = 1.189207115002721f;
constexpr float SC_W = 64.f, SC_H = 8.f, SC_ACT = 4.f, SC_Y = 64.f;
constexpr int NWAVES = 8, NTHR = 512;
constexpr int NPHASE = 10;

constexpr size_t MiB = 1u << 20;
constexpr size_t WS_CTL = 0, CTL_ZERO_BYTES = 1 * MiB;
constexpr size_t WS_XB = 1 * MiB;
constexpr size_t WS_WINT = 33 * MiB;
constexpr size_t WS_WOUTT = 53 * MiB;
constexpr size_t WS_QB = 61 * MiB;
constexpr size_t WS_KB = 77 * MiB;
constexpr size_t WS_VB = 93 * MiB;
constexpr size_t WS_UB = 109 * MiB;
constexpr size_t WS_ALIST = 125 * MiB;
constexpr size_t WS_LSE = 133 * MiB;
constexpr size_t WS_OPART = 134 * MiB;
constexpr size_t WS_MIXIN = 198 * MiB;
constexpr size_t WS_H1 = 230 * MiB;
constexpr size_t WS_TOKROW = 294 * MiB;
constexpr size_t WS_GATE = 295 * MiB;
constexpr size_t WS_WGUT = 296 * MiB;
constexpr size_t WS_WDT = 808 * MiB;
constexpr size_t WS_XG = 1064 * MiB;
constexpr size_t WS_ACT = 2088 * MiB;
constexpr size_t WS_H1B = 3112 * MiB;
constexpr size_t WS_WRT = 3144 * MiB;
constexpr size_t WS_TOKLIST = 3145 * MiB;
constexpr size_t WS_H8 = 3146 * MiB;
constexpr size_t WS_IDLIST = 3162 * MiB;
constexpr size_t WS_END = 3163 * MiB;
constexpr int CW_BAR = 4096;
constexpr int CW_ECNT = 8192;
constexpr int CW_CQ = 12416, CW_READY = 12480;
constexpr int CW_GQ = 49152;
constexpr int CW_AQ = 12288;
constexpr int CW_ECNT2 = 10240, CW_ACNT2 = 32768;
constexpr int CW_ACNT = 16384;
constexpr size_t CTL_KSUM = 262144;

constexpr int RING_BYTES = 131072;
constexpr int MISC_OFF = RING_BYTES;
constexpr int LDS_BYTES = RING_BYTES + 16384;

__device__ __forceinline__ unsigned cvt_pk_bf16(float lo, float hi) { unsigned r; asm volatile("v_cvt_pk_bf16_f32 %0, %1, %2" : "=v"(r) : "v"(lo), "v"(hi)); return r; }
__device__ __forceinline__ unsigned cvt4_fp8(float a, float b, float c, float d) {
    a = __builtin_amdgcn_fmed3f(a, -448.f, 448.f); b = __builtin_amdgcn_fmed3f(b, -448.f, 448.f); c = __builtin_amdgcn_fmed3f(c, -448.f, 448.f); d = __builtin_amdgcn_fmed3f(d, -448.f, 448.f);
    int w = __builtin_amdgcn_cvt_pk_fp8_f32(a, b, 0, false); w = __builtin_amdgcn_cvt_pk_fp8_f32(c, d, w, true); return (unsigned)w; }
__device__ __forceinline__ float bf_lo(unsigned w) { return __builtin_bit_cast(float, w << 16); }
__device__ __forceinline__ float bf_hi(unsigned w) { return __builtin_bit_cast(float, w & 0xffff0000u); }
__device__ __forceinline__ float wave_sum(float v) {
#pragma unroll
    for (int o = 1; o < 64; o <<= 1) v += __shfl_xor(v, o);
    return v;
}
__device__ __forceinline__ float fast_sigmoid(float x) { return __builtin_amdgcn_rcpf(1.f + __builtin_amdgcn_exp2f(-x * 1.4426950408889634f)); }
#define VM_WAIT() asm volatile("s_waitcnt vmcnt(0)" ::: "memory")
#define LDS_WAIT() asm volatile("s_waitcnt lgkmcnt(0)" ::: "memory")

#define XB_TMO      128
#define XB_XCNT(j)  (256  + 64 * (j))
#define XB_XSUB(j)  (1280 + 64 * (j))
#define XB_XGEN(j)  (2304 + 64 * (j))
#define XB_TOP      3328
#define XB_TOPGEN   3392
#define XCD_BAR_WORDS 3456
#define XB_SPIN_CAP (1u << 18)
__device__ __forceinline__ unsigned xb_ld(unsigned* p)              { return __hip_atomic_load(p, __ATOMIC_RELAXED, __HIP_MEMORY_SCOPE_AGENT); }
__device__ __forceinline__ unsigned xb_add(unsigned* p, unsigned v) { return __hip_atomic_fetch_add(p, v, __ATOMIC_RELAXED, __HIP_MEMORY_SCOPE_AGENT); }
__device__ __forceinline__ unsigned xb_xcc_id() { return (unsigned)__builtin_amdgcn_s_getreg((3 << 11) | 20) & 0xFu; }
#define XB_SPIN(cond, bar) do { unsigned _sp = 0; while (cond) { __builtin_amdgcn_s_sleep(1); \
    if ((++_sp & 255u) == 0u) { if (xb_ld(&(bar)[XB_TMO])) break; if (_sp > XB_SPIN_CAP) { atomicAdd(&(bar)[XB_TMO], 1u); break; } } } } while (0)
struct XcdBarrier { unsigned* bar; unsigned x; volatile LAS unsigned* st; };
__device__ __forceinline__ XcdBarrier xcd_barrier_post(unsigned* bar, volatile LAS unsigned* st) {
    XcdBarrier b; b.bar = bar; b.x = xb_xcc_id(); b.st = st;
    if (threadIdx.x == 0) (void)xb_add(&bar[XB_XCNT(b.x)], 1u);
    return b;
}
__device__ __forceinline__ void xcd_barrier_complete(unsigned* bar, unsigned x, unsigned& nloc, unsigned& nx) {
    const unsigned G = gridDim.x * gridDim.y * gridDim.z;
    unsigned sum, cnt, mine, sp = 0u;
    for (;;) {
        sum = 0u; cnt = 0u; mine = 0u;
#pragma unroll
        for (unsigned j = 0; j < 16; ++j) { const unsigned c = xb_ld(&bar[XB_XCNT(j)]); sum += c; cnt += (c > 0u) ? 1u : 0u; mine = (j == x) ? c : mine; }
        if (sum == G) break;
        __builtin_amdgcn_s_sleep(1);
        if ((++sp & 255u) == 0u) { if (xb_ld(&bar[XB_TMO])) break; if (sp > XB_SPIN_CAP) { atomicAdd(&bar[XB_TMO], 1u); break; } }
    }
    nloc = mine > 0u ? mine : 1u; nx = cnt > 0u ? cnt : 1u;
}
__device__ __forceinline__ void xcd_barrier(const XcdBarrier& b) {
    asm volatile("s_waitcnt vmcnt(0)" ::: "memory");
    __syncthreads();
    if (threadIdx.x == 0) {
        unsigned* bar = b.bar;
        __builtin_amdgcn_s_waitcnt(0);
        unsigned nloc = b.st[0], nx = b.st[1];
        if (nloc == 0u) { xcd_barrier_complete(bar, b.x, nloc, nx); b.st[0] = nloc; b.st[1] = nx; }
        const unsigned old = xb_add(&bar[XB_XSUB(b.x)], 1u);
        const unsigned gen = old / nloc;
        if (old + 1u == (gen + 1u) * nloc) {
            __builtin_amdgcn_fence(__ATOMIC_RELEASE, "agent");
            asm volatile("s_waitcnt vmcnt(0)" ::: "memory");
            const unsigned og = xb_add(&bar[XB_TOP], 1u);
            const unsigned tg = og / nx;
            if (og + 1u == (tg + 1u) * nx) xb_add(&bar[XB_TOPGEN], 1u);
            else XB_SPIN(xb_ld(&bar[XB_TOPGEN]) == tg, bar);
            __builtin_amdgcn_fence(__ATOMIC_ACQUIRE, "agent");
            xb_add(&bar[XB_XGEN(b.x)], 1u);
            asm volatile("s_waitcnt vmcnt(0)" ::: "memory");
        } else {
            XB_SPIN(xb_ld(&bar[XB_XGEN(b.x)]) == gen, bar);
            __builtin_amdgcn_fence(__ATOMIC_ACQUIRE, "agent");
            asm volatile("s_waitcnt vmcnt(0)" ::: "memory");
        }
    }
    __syncthreads();
}

namespace pg8 {
constexpr int BM = 256, BK = 64, HALF = 128, HTB = HALF * BK * 2, STAGE_BYTES = 8 * HTB, NXCD = 8, WGM = 8;
constexpr int GK = 2048, S_ROWS = 8192;
__host__ __device__ __forceinline__ int lds_byte(int r, int c) { const int st = (r >> 4) * 2 + (c >> 5), rr = r & 15, cc = c & 31, ob = rr * 64 + cc * 2; return st * 1024 + (ob ^ (((ob >> 9) & 1) << 5)); }
__host__ __device__ __forceinline__ void stage_rc(int b, int& R, int& C) { const int st = b / 1024, sb = b % 1024, swz = sb ^ (((sb >> 9) & 1) << 5); R = (st >> 1) * 16 + swz / 64; C = (st & 1) * 32 + (swz % 64) / 2; }
__host__ __device__ __forceinline__ int perm32(int rho) { const int n = rho >> 4, i = rho & 15; return 8 * (i >> 2) + 4 * n + (i & 3); }

struct Unit { const char* A; const char* B; const int* tok; int pm, pn, e; int half; };
constexpr size_t TSTEP = (size_t)BM * GK * 2;

struct DenseOrder {
    int nM, nN, nwg, G, c; const char* A; const char* Bt; static constexpr unsigned maxrow = 1u;
    __device__ void init(int M, int N, int G_, int c_, const void* A_, const void* Bt_) { nM = M / BM; nN = N / BM; nwg = nM * nN; G = G_; c = c_; A = (const char*)A_; Bt = (const char*)Bt_; }
    unsigned* q;
    __device__ __forceinline__ bool decode(int L, Unit& u) const {
        if (L >= nwg) return false;
        int wgid = L; { const int q = nwg / NXCD, r = nwg % NXCD, xcd = wgid % NXCD, off = wgid / NXCD; wgid = (xcd < r ? xcd * (q + 1) : r * (q + 1) + (xcd - r) * q) + off; }
        const int nig = WGM * nN, gid = wgid / nig, fm = gid * WGM, gsz = (nM - fm) < WGM ? (nM - fm) : WGM;
        u.pm = fm + ((wgid % nig) % gsz); u.pn = (wgid % nig) / gsz; u.e = 0;
        u.A = A + (size_t)u.pm * TSTEP; u.B = Bt + (size_t)u.pn * TSTEP; u.tok = nullptr; return true;
    }
};
struct MoeOrder {
    const volatile LAS int* pfx; int npn, G, c; const char* A; const char* Bt; size_t a_es, b_es; size_t ts  ; const int* toklist; unsigned maxrow  ;
    unsigned* q;
    __device__ __forceinline__ bool decode(int L, Unit& u) const {
        const int total = pfx[NE] * npn; if (L >= total) return false;
        const int gm = L / npn, pn = L - gm * npn;
        int e = 0;
#pragma unroll
        for (int s = 16; s >= 1; s >>= 1) { if (pfx[e + s] <= gm) e += s; }
        e = __builtin_amdgcn_readfirstlane(e);
        const int mt = __builtin_amdgcn_readfirstlane(gm - pfx[e]);
        u.pm = mt; u.pn = pn; u.e = e; u.half = __builtin_amdgcn_readfirstlane((pfx[40 + e] - mt * BM) <= HALF ? 1 : 0);
        u.A = toklist ? A : A + (size_t)e * a_es + (size_t)mt * ts; u.B = Bt + (size_t)e * b_es + (size_t)pn * ts; u.tok = toklist ? toklist + (size_t)e * ECAP + mt * BM : nullptr; return true;
    }
};

typedef int v8i __attribute__((ext_vector_type(8)));
template <class Epi, class Sched, bool GATHER = false, bool FP8 = false>
__device__ __forceinline__ void gemm_phase(LAS unsigned char* lds, const Sched& S, const Epi& E, LAS int* tokl) {
    const int tid = threadIdx.x, wid = __builtin_amdgcn_readfirstlane(tid >> 6), lane = tid & 63, wr = wid >> 2, wc = wid & 3, fr = lane & 15, fq = lane >> 4;
    constexpr int K = FP8 ? GK / 2 : GK, nt = K / BK;
    unsigned vc[2][2], voffB[2];
#pragma unroll
    for (int i = 0; i < 2; ++i) { int R, C; stage_rc(tid * 16 + i * 8192, R, C); const int Rb = Epi::PERM ? ((R & ~31) + perm32(R & 31)) : R;
        voffB[i] = (unsigned)(Rb * K + C) * 2u;
#pragma unroll
        for (int h = 0; h < 2; ++h) vc[h][i] = (unsigned)((R + HALF * h) * K + C) * 2u; }
#define PG8_GATHER_OFFS(TOKPTR) do { int _tz = threadIdx.x; asm volatile("" : "+v"(_tz)); _Pragma("unroll") for (int _i = 0; _i < 2; ++_i) { int _R, _C; stage_rc(_tz * 16 + _i * 8192, _R, _C); \
        _Pragma("unroll") for (int _h = 0; _h < 2; ++_h) { unsigned _tk = (unsigned)(TOKPTR)[_R + HALF * _h]; _tk = _tk < S.maxrow ? _tk : S.maxrow - 1u; vc[_h][_i] = (_tk * K + (unsigned)_C) * 2u; } } } while (0)
    constexpr size_t kstep = (size_t)(BK * 2);
    constexpr size_t hstep = (size_t)HALF * K * 2;
    const unsigned ldsw = (unsigned)wid * 1024u;
    const int aoff = lds_byte(wr * 64 + fr, fq * 8), boff = lds_byte(wc * 32 + fr, fq * 8);
#define PG8_SA(b, h) (((b) * 2 + (h)) * HTB)
#define PG8_SB(b, h) ((4 + (b) * 2 + (h)) * HTB)
#define PG8_STAGE(bufoff, gbase, voff) do { _Pragma("unroll") for (int _i = 0; _i < 2; ++_i) \
        __builtin_amdgcn_global_load_lds((const unsigned*)((const char*)(gbase) + (voff)[_i]), (LAS unsigned*)(lds + (bufoff) + ldsw + _i * 8192), 16, 0, 0); } while (0)
#define PG8_LDA(dst, b, h) do { _Pragma("unroll") for (int m = 0; m < 4; ++m) _Pragma("unroll") for (int k = 0; k < 2; ++k) dst[m][k] = *(const LAS bf16x8*)(lds + PG8_SA(b, h) + aoff + m * 2048 + k * 1024); } while (0)
#define PG8_LDB(dst, b, h) do { _Pragma("unroll") for (int n = 0; n < 2; ++n) _Pragma("unroll") for (int k = 0; k < 2; ++k) dst[n][k] = *(const LAS bf16x8*)(lds + PG8_SB(b, h) + boff + n * 2048 + k * 1024); } while (0)
struct Frag2 { bf16x8 a, b; };
#define PG8_CAT(x) (Frag2{x[0], x[1]})
#define PG8_MMA(ai, bj, At, Bt) do { __builtin_amdgcn_s_setprio(1); _Pragma("unroll") for (int m = 0; m < 4; ++m) _Pragma("unroll") for (int n = 0; n < 2; ++n) { \
        if constexpr (FP8) acc[ai][bj][m][n] = __builtin_amdgcn_mfma_scale_f32_16x16x128_f8f6f4(__builtin_bit_cast(v8i, PG8_CAT(Bt[n])), __builtin_bit_cast(v8i, PG8_CAT(At[m])), acc[ai][bj][m][n], 0, 0, 0, 0x7f7f7f7f, 0, 0x7f7f7f7f); \
        else { _Pragma("unroll") for (int k = 0; k < 2; ++k) acc[ai][bj][m][n] = __builtin_amdgcn_mfma_f32_16x16x32_bf16(Bt[n][k], At[m][k], acc[ai][bj][m][n], 0, 0, 0); } } \
        __builtin_amdgcn_s_setprio(0); } while (0)
#define PG8_WAIT_V(n) asm volatile("s_waitcnt vmcnt(" #n ")" ::: "memory")
#define PG8_WAIT_L(n) asm volatile("s_waitcnt lgkmcnt(" #n ")" ::: "memory")
#define PG8_BAR __builtin_amdgcn_s_barrier()
#define PG8_SCHED __builtin_amdgcn_sched_barrier(0)
    const int label = blockIdx.x & 7; unsigned* qp = S.q + label * 64; const bool dyn = S.q != nullptr;
    volatile LAS int* qs = (volatile LAS int*)(tokl + 2 * BM);
    int jnxt;
    if (dyn) { if (tid == 0) qs[0] = (int)xb_add(qp, 2u); __syncthreads(); jnxt = qs[0] + 1; }
    else jnxt = (int)(blockIdx.x >> 3) + 1;
    Unit cur, nxt; int ui = 0;
    if (!S.decode((jnxt - 1) * 8 + label, cur)) return;
    if (!dyn) jnxt += 31;
    f32x4 acc[2][2][4][2];
#pragma unroll
    for (int a = 0; a < 2; ++a)
#pragma unroll
        for (int b = 0; b < 2; ++b)
#pragma unroll
            for (int m = 0; m < 4; ++m)
#pragma unroll
                for (int n = 0; n < 2; ++n) acc[a][b][m][n] = (f32x4){0.f, 0.f, 0.f, 0.f};
    bf16x8 At[4][2], B0[2][2], B1[2][2];
    const char* cA = cur.A; const char* cB = cur.B;
    LAS float* epl = (LAS float*)((LAS char*)tokl + 4096);
    int eb = 0;
    if constexpr (Epi::STAGE) { if (wid == 0) E.stage(cur, lane, epl); }
    if constexpr (GATHER) PG8_GATHER_OFFS(cur.tok);
    PG8_STAGE(PG8_SB(0, 0), cB, voffB); PG8_STAGE(PG8_SB(0, 1), cB + hstep, voffB); PG8_STAGE(PG8_SA(0, 0), cA, vc[0]); PG8_STAGE(PG8_SA(0, 1), cA, vc[1]);
    if (wr == 1) PG8_BAR;
    PG8_WAIT_V(2); PG8_BAR;
    PG8_STAGE(PG8_SB(1, 0), cB + kstep, voffB); PG8_STAGE(PG8_SA(1, 0), cA + kstep, vc[0]); PG8_STAGE(PG8_SB(1, 1), cB + hstep + kstep, voffB);
    PG8_WAIT_V(6); PG8_BAR;
    for (;;) {
        const bool has_next = S.decode(jnxt * 8 + label, nxt);
        unsigned jreq = 0u;
        if (dyn && tid == 0) jreq = xb_add(qp, 1u);
        const char* nA = has_next ? nxt.A : cA; const char* nB = has_next ? nxt.B : cB;
        if constexpr (GATHER) {
            if (has_next && wid == 0) __builtin_amdgcn_global_load_lds((const unsigned*)(nxt.tok + lane * 4), (LAS unsigned*)(tokl + ((ui + 1) & 1) * BM), 16, 0, 0);
        }
        const int nb = (eb == 2) ? 0 : eb + 1;
        if constexpr (Epi::STAGE) { if (has_next && wid == 0) E.stage(nxt, lane, epl + nb * 512); }
        if (GATHER && FP8 && cur.half != 0) {
            for (int t = 0; t < nt; t += 2) {
                const bool last = (t == nt - 2);
                const char* a1 = cA + (size_t)(t + 1) * kstep;
                const char* a2 = last ? nA : cA + (size_t)(t + 2) * kstep; const char* b2 = last ? nB : cB + (size_t)(t + 2) * kstep;
                const char* a3 = a2 + kstep; const char* b3 = b2 + kstep;
                PG8_LDB(B0, 0, 0); PG8_LDB(B1, 0, 1); PG8_SCHED; PG8_LDA(At, 0, 0); PG8_STAGE(PG8_SA(1, 1), a1, vc[1]);
                if constexpr (GATHER) { if (last && has_next) PG8_GATHER_OFFS(tokl + ((ui + 1) & 1) * BM); }
                if (dyn && last && tid == 0) { asm volatile("" : "+v"(jreq)); qs[1 + (ui & 1)] = (int)jreq; }
                PG8_WAIT_V(8); PG8_WAIT_L(0); PG8_BAR; PG8_MMA(0, 0, At, B0); PG8_MMA(0, 1, At, B1); PG8_BAR; PG8_SCHED;
                PG8_STAGE(PG8_SB(0, 0), b2, voffB); PG8_STAGE(PG8_SB(0, 1), b2 + hstep, voffB); PG8_STAGE(PG8_SA(0, 0), a2, vc[0]);
                PG8_WAIT_V(8); PG8_WAIT_L(0); PG8_BAR; asm volatile("s_nop 7\n\ts_nop 7" ::: "memory"); PG8_BAR; PG8_SCHED;
                PG8_LDB(B0, 1, 0); PG8_LDB(B1, 1, 1); PG8_SCHED; PG8_LDA(At, 1, 0); PG8_STAGE(PG8_SA(0, 1), a2, vc[1]);
                PG8_WAIT_V(8); PG8_WAIT_L(0); PG8_BAR; PG8_MMA(0, 0, At, B0); PG8_MMA(0, 1, At, B1); PG8_BAR; PG8_SCHED;
                PG8_STAGE(PG8_SB(1, 0), b3, voffB); PG8_STAGE(PG8_SB(1, 1), b3 + hstep, voffB); PG8_STAGE(PG8_SA(1, 0), a3, vc[0]);
                PG8_WAIT_V(8); PG8_WAIT_L(0); PG8_BAR; asm volatile("s_nop 7\n\ts_nop 7" ::: "memory"); PG8_BAR; PG8_SCHED;
            }
        } else {
            for (int t = 0; t < nt; t += 2) {
                const bool last = (t == nt - 2);
                const char* a1 = cA + (size_t)(t + 1) * kstep;
                const char* a2 = last ? nA : cA + (size_t)(t + 2) * kstep; const char* b2 = last ? nB : cB + (size_t)(t + 2) * kstep;
                const char* a3 = a2 + kstep; const char* b3 = b2 + kstep;
                PG8_LDB(B0, 0, 0); PG8_LDB(B1, 0, 1); PG8_SCHED; PG8_LDA(At, 0, 0); PG8_STAGE(PG8_SA(1, 1), a1, vc[1]);
                if constexpr (GATHER) { if (last && has_next) PG8_GATHER_OFFS(tokl + ((ui + 1) & 1) * BM); }
                if (dyn && last && tid == 0) { asm volatile("" : "+v"(jreq)); qs[1 + (ui & 1)] = (int)jreq; }
                PG8_WAIT_V(8); PG8_WAIT_L(0); PG8_BAR; PG8_MMA(0, 0, At, B0); PG8_MMA(0, 1, At, B1); PG8_BAR; PG8_SCHED;
                PG8_LDA(At, 0, 1); PG8_STAGE(PG8_SB(0, 0), b2, voffB); PG8_STAGE(PG8_SB(0, 1), b2 + hstep, voffB); PG8_STAGE(PG8_SA(0, 0), a2, vc[0]);
                PG8_WAIT_V(8); PG8_WAIT_L(0); PG8_BAR; PG8_MMA(1, 0, At, B0); PG8_MMA(1, 1, At, B1); PG8_BAR; PG8_SCHED;
                PG8_LDB(B0, 1, 0); PG8_LDB(B1, 1, 1); PG8_SCHED; PG8_LDA(At, 1, 0); PG8_STAGE(PG8_SA(0, 1), a2, vc[1]);
                PG8_WAIT_V(8); PG8_WAIT_L(0); PG8_BAR; PG8_MMA(0, 0, At, B0); PG8_MMA(0, 1, At, B1); PG8_BAR; PG8_SCHED;
                PG8_LDA(At, 1, 1); PG8_STAGE(PG8_SB(1, 0), b3, voffB); PG8_STAGE(PG8_SB(1, 1), b3 + hstep, voffB); PG8_STAGE(PG8_SA(1, 0), a3, vc[0]);
                PG8_WAIT_V(8); PG8_WAIT_L(0); PG8_BAR; PG8_MMA(1, 0, At, B0); PG8_MMA(1, 1, At, B1); PG8_BAR; PG8_SCHED;
            }
        }
        if (wr == 0) PG8_BAR;
        { int tz = threadIdx.x; asm volatile("" : "+v"(tz)); const int lz = tz & 63; E(acc, cur, wr, wc, lz & 15, lz >> 4, epl + eb * 512); }
        if (!has_next) break;
#pragma unroll
        for (int a = 0; a < 2; ++a)
#pragma unroll
            for (int b = 0; b < 2; ++b)
#pragma unroll
                for (int m = 0; m < 4; ++m)
#pragma unroll
                    for (int n = 0; n < 2; ++n) acc[a][b][m][n] = (f32x4){0.f, 0.f, 0.f, 0.f};
        jnxt = dyn ? qs[1 + (ui & 1)] : jnxt + 32;
        cur = nxt; cA = nA; cB = nB; ++ui; eb = nb;
        if (wr == 1) PG8_BAR;
    }
    PG8_WAIT_V(0);
    PG8_BAR;
#undef PG8_SA
#undef PG8_SB
#undef PG8_STAGE
#undef PG8_LDA
#undef PG8_LDB
#undef PG8_MMA
#undef PG8_CAT
#undef PG8_GATHER_OFFS
#undef PG8_WAIT_V
#undef PG8_WAIT_L
#undef PG8_BAR
#undef PG8_SCHED
}

struct EpiInProj {
    static constexpr bool PERM = true; static constexpr bool STAGE = false;
    bf16_t *Q, *U; float* ksum;
    __device__ __forceinline__ void operator()(const f32x4 (&acc)[2][2][4][2], const Unit& u, int wr, int wc, int fr, int fq, const LAS float* lb) const {
        const int row0 = u.pm * BM + wr * 64 + fr;
        if (u.pn < 12) {
            const int t = u.pn >> 2; bf16_t* base = Q + (size_t)t * ((WS_KB - WS_QB) / 2);
            const int col0 = (u.pn & 3) * 256 + wc * 32 + 8 * fq;
#pragma unroll
            for (int ai = 0; ai < 2; ++ai)
#pragma unroll
                for (int m = 0; m < 4; ++m) { bf16_t* rowp = base + (size_t)(row0 + ai * HALF + m * 16) * DA + col0;
#pragma unroll
                    for (int bj = 0; bj < 2; ++bj) { const f32x4 v0 = acc[ai][bj][m][0], v1 = acc[ai][bj][m][1];
                        u32x4 w; w.x = cvt_pk_bf16(v0[0], v0[1]); w.y = cvt_pk_bf16(v0[2], v0[3]); w.z = cvt_pk_bf16(v1[0], v1[1]); w.w = cvt_pk_bf16(v1[2], v1[3]);
                        *(u32x4*)(rowp + bj * HALF) = w; } }
            if (t == 1) {
#pragma unroll
                for (int bj = 0; bj < 2; ++bj)
#pragma unroll
                    for (int n = 0; n < 2; ++n) { f32x4 s = (f32x4){0.f, 0.f, 0.f, 0.f};
#pragma unroll
                        for (int ai = 0; ai < 2; ++ai)
#pragma unroll
                            for (int m = 0; m < 4; ++m) s += acc[ai][bj][m][n];
#pragma unroll
                        for (int e = 0; e < 4; ++e) { float v = s[e]; v += __shfl_xor(v, 1); v += __shfl_xor(v, 2); v += __shfl_xor(v, 4); v += __shfl_xor(v, 8);
                            if (fr == 0) atomicAdd(ksum + (size_t)u.pm * DA + col0 + bj * HALF + 4 * n + e, v); } }
            }
        } else {
            const int ch0 = (u.pn - 12) * 128 + wc * 32 + 8 * fq;
#pragma unroll
            for (int ai = 0; ai < 2; ++ai)
#pragma unroll
                for (int m = 0; m < 4; ++m) { bf16_t* rowp = U + (size_t)(row0 + ai * HALF + m * 16) * DC + ch0;
                    float o[8];
#pragma unroll
                    for (int n = 0; n < 2; ++n)
#pragma unroll
                        for (int e = 0; e < 4; ++e) o[n * 4 + e] = acc[ai][0][m][n][e] * fast_sigmoid(acc[ai][1][m][n][e]);
                    u32x4 w; w.x = cvt_pk_bf16(o[0], o[1]); w.y = cvt_pk_bf16(o[2], o[3]); w.z = cvt_pk_bf16(o[4], o[5]); w.w = cvt_pk_bf16(o[6], o[7]);
                    *(u32x4*)rowp = w; }
        }
    }
};
struct EpiOutProj {
    static constexpr bool PERM = true; static constexpr bool STAGE = false;
    const bf16_t* X; bf16_t* H;
    __device__ __forceinline__ void operator()(const f32x4 (&acc)[2][2][4][2], const Unit& u, int wr, int wc, int fr, int fq, const LAS float* lb) const {
        const int row0 = u.pm * BM + wr * 64 + fr, col0 = u.pn * BM + wc * 32 + 8 * fq;
#pragma unroll
        for (int ai = 0; ai < 2; ++ai)
#pragma unroll
            for (int m = 0; m < 4; ++m) { const size_t off = (size_t)(row0 + ai * HALF + m * 16) * DM + col0;
#pragma unroll
                for (int bj = 0; bj < 2; ++bj) { const u32x4 xw = *(const u32x4*)(X + off + bj * HALF);
                    const f32x4 x0 = (f32x4){bf_lo(xw.x), bf_hi(xw.x), bf_lo(xw.y), bf_hi(xw.y)}, x1 = (f32x4){bf_lo(xw.z), bf_hi(xw.z), bf_lo(xw.w), bf_hi(xw.w)};
                    const f32x4 v0 = x0 * DN_ALPHA + acc[ai][bj][m][0], v1 = x1 * DN_ALPHA + acc[ai][bj][m][1];
                    u32x4 w; w.x = cvt_pk_bf16(v0[0], v0[1]); w.y = cvt_pk_bf16(v0[2], v0[3]); w.z = cvt_pk_bf16(v1[0], v1[1]); w.w = cvt_pk_bf16(v1[2], v1[3]);
                    *(u32x4*)(H + off + bj * HALF) = w; } }
    }
};
struct EpiGateUp {
    static constexpr bool PERM = true; static constexpr bool STAGE = true;
    __device__ __forceinline__ void stage(const Unit& u, int lane, LAS float* dst) const {
        const float* src = bias + (size_t)u.e * 4096 + u.pn * 128 + (lane & 31) * 4 + (lane >> 5) * 2048;
        __builtin_amdgcn_global_load_lds((const unsigned*)src, (LAS unsigned*)dst, 16, 0, 0); }
    unsigned char* ACT; const float* bias;
    __device__ __forceinline__ void operator()(const f32x4 (&acc)[2][2][4][2], const Unit& u, int wr, int wc, int fr, int fq, const LAS float* lb) const {
        const int row0 = u.pm * BM + wr * 64 + fr, ch0 = u.pn * 128 + wc * 32 + 8 * fq;
        const LAS float* bg = lb + wc * 32 + 8 * fq;
        f32x4 bgv[2], buv[2];
#pragma unroll
        for (int n = 0; n < 2; ++n) { bgv[n] = *(const LAS f32x4*)(bg + 4 * n); buv[n] = *(const LAS f32x4*)(bg + 128 + 4 * n); }
        unsigned char* base = ACT + (size_t)u.e * ECAP * DFF;
        constexpr float inv = 1.f / (SC_H * SC_W);
#pragma unroll
        for (int ai = 0; ai < 2; ++ai)
#pragma unroll
            for (int m = 0; m < 4; ++m) { unsigned char* rowp = base + (size_t)(row0 + ai * HALF + m * 16) * DFF + ch0;
                float o[8];
#pragma unroll
                for (int n = 0; n < 2; ++n)
#pragma unroll
                    for (int e = 0; e < 4; ++e) { float g = acc[ai][0][m][n][e] * inv + bgv[n][e], uu = acc[ai][1][m][n][e] * inv + buv[n][e];
                        g = fminf(g, 7.f); uu = fminf(fmaxf(uu, -7.f), 7.f);
                        o[n * 4 + e] = (uu + 1.f) * (g * fast_sigmoid(1.702f * g)) * SC_ACT; }
                u32x2 w; w.x = cvt4_fp8(o[0], o[1], o[2], o[3]); w.y = cvt4_fp8(o[4], o[5], o[6], o[7]);
                *(u32x2*)rowp = w; }
    }
};
struct EpiDown {
    static constexpr bool PERM = true; static constexpr bool STAGE = true;
    __device__ __forceinline__ void stage(const Unit& u, int lane, LAS float* dst) const {
        __builtin_amdgcn_global_load_lds((const unsigned*)(bias + (size_t)u.e * DM + u.pn * BM + lane * 4), (LAS unsigned*)dst, 16, 0, 0);
        __builtin_amdgcn_global_load_lds((const unsigned*)(gate + (size_t)u.e * ECAP + u.pm * BM + lane * 4), (LAS unsigned*)(dst + 256), 16, 0, 0); }
    unsigned char* Y; const float* bias; const float* gate;
    __device__ __forceinline__ void operator()(const f32x4 (&acc)[2][2][4][2], const Unit& u, int wr, int wc, int fr, int fq, const LAS float* lb) const {
        const int row0 = u.pm * BM + wr * 64 + fr, col0 = u.pn * BM + wc * 32 + 8 * fq;
        const LAS float* bb = lb + wc * 32 + 8 * fq;
        unsigned char* base = Y + (size_t)u.e * ECAP * DM; const LAS float* gp = lb + 256 - u.pm * BM;
        constexpr float inv = 1.f / (SC_ACT * SC_W);
#pragma unroll
        for (int bj = 0; bj < 2; ++bj) { const f32x4 b0 = *(const LAS f32x4*)(bb + bj * HALF), b1 = *(const LAS f32x4*)(bb + bj * HALF + 4);
#pragma unroll
            for (int ai = 0; ai < 2; ++ai)
#pragma unroll
                for (int m = 0; m < 4; ++m) { const int row = row0 + ai * HALF + m * 16; const float gt = gp[row] * SC_Y;
                    const f32x4 v0 = (acc[ai][bj][m][0] * inv + b0) * gt, v1 = (acc[ai][bj][m][1] * inv + b1) * gt;
                    u32x2 w; w.x = cvt4_fp8(v0[0], v0[1], v0[2], v0[3]); w.y = cvt4_fp8(v1[0], v1[1], v1[2], v1[3]);
                    *(u32x2*)(base + (size_t)row * DM + col0 + bj * HALF) = w; }
            asm volatile("" ::: "memory"); }
    }
};
}

struct Args { const float* in[17]; float* out; unsigned char* ws; int ph_lo, ph_hi; };
enum { I_X = 0, I_WIN, I_CONVW, I_CONVB, I_CLNG, I_CLNB, I_WOUT, I_LN1G, I_LN1B, I_WR, I_BR, I_WGU, I_BGU, I_WD, I_BD, I_LN2G, I_LN2B };

__device__ __forceinline__ int rowmap(int mode, int n) {
    if (mode == 1) {
        if (n < 3072) return n;
        if (n < 4096) { const int c = n - 3072; return 3072 + (c >> 7) * 256 + (c & 127); }
        const int c = n - 4096; return 3072 + (c >> 7) * 256 + 128 + (c & 127);
    }
    if (mode == 2) {
        if (n < 2048) return (n >> 7) * 256 + (n & 127);
        const int c = n - 2048; return (c >> 7) * 256 + 128 + (c & 127);
    }
    return n;
}
struct TItem { const float* src; bf16_t* dst; int N, mode, k0, n0; };
constexpr int TI_WIN = 32 * 20, TI_WOUT = 32 * 8, TI_GU = 32 * 32 * 16, TI_D = 32 * 32 * 8, TI_ALL = TI_WIN + TI_WOUT + TI_GU + TI_D;
__device__ __forceinline__ TItem t_decode(const Args& a, int it) {
    TItem r;
    if (it < TI_WIN) { r.src = a.in[I_WIN]; r.dst = (bf16_t*)(a.ws + WS_WINT); r.N = INCOLS; r.mode = 1; r.k0 = (it / 20) * 64; r.n0 = (it % 20) * 256; return r; }
    it -= TI_WIN;
    if (it < TI_WOUT) { r.src = a.in[I_WOUT]; r.dst = (bf16_t*)(a.ws + WS_WOUTT); r.N = DM; r.mode = 0; r.k0 = (it / 8) * 64; r.n0 = (it % 8) * 256; return r; }
    it -= TI_WOUT;
    if (it < TI_GU) { const int e = it / 512, j = it % 512; r.src = a.in[I_WGU] + (size_t)e * 2048 * 4096; r.dst = (bf16_t*)(a.ws + WS_WGUT + (size_t)e * 4096 * 2048); r.N = 4096; r.mode = 2; r.k0 = (j / 32) * 128; r.n0 = (j % 32) * 128; return r; }
    it -= TI_GU;
    { const int e = it / 256, j = it % 256; r.src = a.in[I_WD] + (size_t)e * 2048 * 2048; r.dst = (bf16_t*)(a.ws + WS_WDT + (size_t)e * 2048 * 2048); r.N = 2048; r.mode = 0; r.k0 = (j / 16) * 128; r.n0 = (j % 16) * 128; return r; }
}
__device__ __forceinline__ void t_load(const TItem& it, f32x4 (&v)[8], int tid) {
    const int kq = tid >> 6, nl = tid & 63;
    const float* p = it.src + (size_t)(it.k0 + kq * 8) * it.N + it.n0 + 4 * nl;
#pragma unroll
    for (int i = 0; i < 8; ++i) v[i] = *(const f32x4*)(p + (size_t)i * it.N);
}
__device__ __forceinline__ void t_process(const TItem& it, const f32x4 (&v)[8], LAS unsigned char* scr, int tid) {
    const int kq = tid >> 6, nl = tid & 63;
#pragma unroll
    for (int j = 0; j < 4; ++j) { u32x4 w; w.x = cvt_pk_bf16(v[0][j], v[1][j]); w.y = cvt_pk_bf16(v[2][j], v[3][j]); w.z = cvt_pk_bf16(v[4][j], v[5][j]); w.w = cvt_pk_bf16(v[6][j], v[7][j]);
        *(LAS u32x4*)(scr + (4 * nl + j) * 128 + ((kq ^ (nl & 7)) * 16)) = w; }
    __syncthreads();
#pragma unroll
    for (int p = 0; p < 4; ++p) { const int r = tid + 512 * p, nn = r >> 3, ch = r & 7;
        const u32x4 w = *(const LAS u32x4*)(scr + nn * 128 + ((ch ^ ((nn >> 2) & 7)) * 16));
        const int row = rowmap(it.mode, it.n0 + nn);
        *(u32x4*)(it.dst + (size_t)row * 2048 + it.k0 + ch * 8) = w; }
    __syncthreads();
}
__device__ __forceinline__ void t8_load(const TItem& it, f32x4 (&v)[8], int tid) {
    const int kq = tid >> 5, nl = tid & 31;
    const float* p = it.src + (size_t)(it.k0 + kq * 8) * it.N + it.n0 + 4 * nl;
#pragma unroll
    for (int i = 0; i < 8; ++i) v[i] = __builtin_nontemporal_load((const f32x4*)(p + (size_t)i * it.N));
}
template <bool SYNC2 = true> __device__ __forceinline__ void t8_process(const TItem& it, const f32x4 (&v)[8], LAS unsigned char* scr, int tid) {
    const int kq = tid >> 5, nl = tid & 31;
#pragma unroll
    for (int j = 0; j < 4; ++j) { u32x2 w; w.x = cvt4_fp8(v[0][j] * SC_W, v[1][j] * SC_W, v[2][j] * SC_W, v[3][j] * SC_W); w.y = cvt4_fp8(v[4][j] * SC_W, v[5][j] * SC_W, v[6][j] * SC_W, v[7][j] * SC_W);
        *(LAS u32x2*)(scr + (4 * nl + j) * 128 + (((kq >> 1) ^ (nl & 7)) * 16) + (kq & 1) * 8) = w; }
    __syncthreads();
#pragma unroll
    for (int p = 0; p < 2; ++p) { const int r = tid + 512 * p, nn = r >> 3, ch = r & 7;
        const u32x4 w = *(const LAS u32x4*)(scr + nn * 128 + ((ch ^ ((nn >> 2) & 7)) * 16));
        const int row = rowmap(it.mode, it.n0 + nn);
        __builtin_nontemporal_store(w, (u32x4*)((unsigned char*)it.dst + (size_t)row * 2048 + it.k0 + ch * 16)); }
    if (SYNC2) __syncthreads();
}
constexpr int CQ_N = 0;
constexpr int CV_P1 = 10240, CV_P1_WGS = 128, CV_P7_WGS = 96, CV_P3_WGS = 128;
__device__ __forceinline__ void phase_convert(const Args& a, LAS unsigned char* lds) {
    const int tid = threadIdx.x, G = gridDim.x, c = blockIdx.x;
    { const f32x4* src = (const f32x4*)a.in[I_X]; u32x4* dst = (u32x4*)(a.ws + WS_XB); const size_t n8 = (size_t)S * DM / 8;
      const size_t step = (size_t)G * NTHR;
      for (size_t i0 = (size_t)c * NTHR + tid; i0 < n8; i0 += 4 * step) { f32x4 p[4], q[4];
#pragma unroll
          for (int u = 0; u < 4; ++u) { const size_t i = i0 + u * step; if (i < n8) { p[u] = __builtin_nontemporal_load(src + 2 * i); q[u] = __builtin_nontemporal_load(src + 2 * i + 1); } }
#pragma unroll
          for (int u = 0; u < 4; ++u) { const size_t i = i0 + u * step; if (i < n8) {
              u32x4 w; w.x = cvt_pk_bf16(p[u][0], p[u][1]); w.y = cvt_pk_bf16(p[u][2], p[u][3]); w.z = cvt_pk_bf16(q[u][0], q[u][1]); w.w = cvt_pk_bf16(q[u][2], q[u][3]); dst[i] = w; } } } }
    { int* idl = (int*)(a.ws + WS_IDLIST); for (int i = c * NTHR + tid; i < NE * ECAP; i += G * NTHR) idl[i] = i; }
    { const float* wr = a.in[I_WR]; bf16_t* img = (bf16_t*)(a.ws + WS_WRT);
      for (int idx = c * NTHR + tid; idx < DM * NE; idx += G * NTHR) { const int j = idx & 7, l = (idx >> 3) & 63, et = (idx >> 9) & 1, ss = idx >> 10;
          const float w = wr[(size_t)(32 * ss + 8 * (l >> 4) + j) * NE + 16 * et + (l & 15)];
          const unsigned hi = cvt_pk_bf16(w, 0.f) & 0xffffu; const float wl = w - bf_lo(hi);
          img[idx] = (bf16_t)hi; img[DM * NE + idx] = (bf16_t)(cvt_pk_bf16(wl, 0.f) & 0xffffu); } }
    f32x4 va[8], vb[8];
    constexpr int TI_BF = TI_WIN + TI_WOUT;
    for (int it = c; it < TI_WIN; it += G) { const TItem ia = t_decode(a, it); t_load(ia, va, tid); t_process(ia, va, lds, tid); }
    int it = TI_BF + TI_GU + c;
    constexpr int TI_ALL0 = TI_BF + TI_GU;
    if (it < TI_ALL0) { TItem ia = t_decode(a, it); t8_load(ia, va, tid);
        for (;;) {
            const int itb = it + G; TItem ib; const bool hb = itb < TI_ALL0; if (hb) { ib = t_decode(a, itb); t8_load(ib, vb, tid); }
            t8_process(ia, va, lds, tid);
            if (!hb) break;
            const int ita = itb + G; const bool ha = ita < TI_ALL0; if (ha) { ia = t_decode(a, ita); t8_load(ia, va, tid); }
            t8_process(ib, vb, lds, tid);
            if (!ha) break;
            it = ita;
        }
    }
}
__device__ __forceinline__ void moe_convert_items(const Args& a, LAS unsigned char* lds, int first, int n) {
    constexpr int TI_BF = TI_WIN + TI_WOUT;
    const int tid = threadIdx.x;
    f32x4 va[8], vb[8], vc[8];
    const int it0 = TI_BF + first, itend = TI_BF + first + n;
    TItem ia, ib, ic;
    if (it0 < itend) { ia = t_decode(a, it0); t8_load(ia, va, tid); }
    if (it0 + 1 < itend) { ib = t_decode(a, it0 + 1); t8_load(ib, vb, tid); }
    for (int it = it0; it < itend; it += 3) {
        if (it + 2 < itend) { ic = t_decode(a, it + 2); t8_load(ic, vc, tid); }
        t8_process<false>(ia, va, lds + ((it - it0) & 1) * 16384, tid);
        if (it + 1 >= itend) break;
        if (it + 3 < itend) { ia = t_decode(a, it + 3); t8_load(ia, va, tid); }
        t8_process<false>(ib, vb, lds + ((it - it0 + 1) & 1) * 16384, tid);
        if (it + 2 >= itend) break;
        if (it + 4 < itend) { ib = t_decode(a, it + 4); t8_load(ib, vb, tid); }
        t8_process<false>(ic, vc, lds + ((it - it0) & 1) * 16384, tid);
    }
    __syncthreads();
}
constexpr int CQ_CHUNK = 2, TI_MOE = TI_GU + TI_D;
__device__ __forceinline__ void cq_drain(const Args& a, LAS unsigned char* lds, volatile LAS int* bc, int limit) {
    unsigned* cq = (unsigned*)(a.ws + WS_CTL) + CW_CQ;
    for (;;) {
        if (threadIdx.x == 0) { int q = -1; if ((int)xb_ld(cq) < limit) { q = (int)xb_add(cq, CQ_CHUNK); if (q >= limit) q = -1; } bc[0] = q; }
        __syncthreads(); const int q = bc[0]; __syncthreads();
        if (q < 0) break;
        moe_convert_items(a, lds, q, CQ_CHUNK);
    }
}
__device__ __forceinline__ void cq_while_waiting(const Args& a, LAS unsigned char* lds, volatile LAS int* bc, unsigned target, int limit) {
    unsigned* cq = (unsigned*)(a.ws + WS_CTL) + CW_CQ; unsigned* ready = (unsigned*)(a.ws + WS_CTL) + CW_READY;
    __syncthreads();
    if (threadIdx.x == 0) (void)xb_add(ready, 1u);
    for (;;) {
        if (threadIdx.x == 0) { int q = -1; if (xb_ld(ready) + 2u < target && (int)xb_ld(cq) < limit) { q = (int)xb_add(cq, CQ_CHUNK); if (q >= limit) q = -1; } bc[0] = q; }
        __syncthreads(); const int q = bc[0]; __syncthreads();
        if (q < 0) break;
        moe_convert_items(a, lds, q, CQ_CHUNK);
    }
}

__device__ __forceinline__ void phase_gate_conv(const Args& a, LAS unsigned char* lds, bool dry) {
    const int tid = threadIdx.x, wid = __builtin_amdgcn_readfirstlane(tid >> 6), lane = tid & 63;
    const bf16_t* QB = (const bf16_t*)(a.ws + WS_QB);
    const float* ksum = (const float*)(a.ws + WS_CTL + CTL_KSUM);
    unsigned* acnt = (unsigned*)(a.ws + WS_CTL) + (dry ? CW_ACNT2 : CW_ACNT);
    int* alist = (int*)(a.ws + (dry ? WS_ACT : WS_ALIST));
    float* LSE = (float*)(a.ws + (dry ? WS_ACT + 16 * MiB : WS_LSE));
    LAS int* lcnt = (LAS int*)(lds + MISC_OFF + 4096);
    LAS int* lbase = lcnt + 256;
    LAS int* selb = lbase + 256;
    for (int chunk = blockIdx.x; chunk < S / 32; chunk += gridDim.x) {
        const int qb = chunk >> 3;
        const int h = wid;
        if (tid < 256) lcnt[tid] = 0;
        __syncthreads();
        const int r32 = lane & 31, hi = lane >> 5;
        const float* kp = ksum + (size_t)r32 * DA + h * HD + hi * 8;
        const bf16_t* qp = QB + (size_t)(chunk * 32 + r32) * DA + h * HD + hi * 8;
        f32x16 sc = {};
#pragma unroll
        for (int ss = 0; ss < 8; ++ss) {
            const f32x4 k0 = *(const f32x4*)(kp + ss * 16), k1 = *(const f32x4*)(kp + ss * 16 + 4);
            const bf16x8 qf = *(const bf16x8*)(qp + ss * 16);
            u32x4 ah, al;
            ah.x = cvt_pk_bf16(k0[0], k0[1]); ah.y = cvt_pk_bf16(k0[2], k0[3]); ah.z = cvt_pk_bf16(k1[0], k1[1]); ah.w = cvt_pk_bf16(k1[2], k1[3]);
            al.x = cvt_pk_bf16(k0[0] - bf_lo(ah.x), k0[1] - bf_hi(ah.x)); al.y = cvt_pk_bf16(k0[2] - bf_lo(ah.y), k0[3] - bf_hi(ah.y));
            al.z = cvt_pk_bf16(k1[0] - bf_lo(ah.z), k1[1] - bf_hi(ah.z)); al.w = cvt_pk_bf16(k1[2] - bf_lo(ah.w), k1[3] - bf_hi(ah.w));
            sc = __builtin_amdgcn_mfma_f32_32x32x16_bf16(__builtin_bit_cast(bf16x8, ah), qf, sc, 0, 0, 0);
            sc = __builtin_amdgcn_mfma_f32_32x32x16_bf16(__builtin_bit_cast(bf16x8, al), qf, sc, 0, 0, 0);
        }
        float v[16];
#pragma unroll
        for (int r = 0; r < 16; ++r) { const int nb = (r & 3) + 8 * (r >> 2) + 4 * hi; v[r] = nb < qb ? sc[r] : -INFINITY; }
        float tv[3]; int ti[3];
#pragma unroll
        for (int s3 = 0; s3 < 3; ++s3) { float bv = v[0]; int bi = 4 * hi;
#pragma unroll
            for (int r = 1; r < 16; ++r) { const int nb = (r & 3) + 8 * (r >> 2) + 4 * hi; if (v[r] > bv) { bv = v[r]; bi = nb; } }
            tv[s3] = bv; ti[s3] = bi;
#pragma unroll
            for (int r = 0; r < 16; ++r) { const int nb = (r & 3) + 8 * (r >> 2) + 4 * hi; if (nb == bi) v[r] = -INFINITY; } }
        float pv3[3]; int pi3[3];
#pragma unroll
        for (int s3 = 0; s3 < 3; ++s3) { pv3[s3] = __shfl_xor(tv[s3], 32); pi3[s3] = __shfl_xor(ti[s3], 32); }
        int sel[3]; { int ia = 0, ib = 0;
#pragma unroll
            for (int s3 = 0; s3 < 3; ++s3) { const float va = ia == 0 ? tv[0] : (ia == 1 ? tv[1] : tv[2]), vb = ib == 0 ? pv3[0] : (ib == 1 ? pv3[1] : pv3[2]);
                const int na = ia == 0 ? ti[0] : (ia == 1 ? ti[1] : ti[2]), nb2 = ib == 0 ? pi3[0] : (ib == 1 ? pi3[1] : pi3[2]);
                const bool ta = (va > vb) || (va == vb && na < nb2);
                const float bv = ta ? va : vb; sel[s3] = (bv == -INFINITY) ? -1 : (ta ? na : nb2);
                if (ta) ++ia; else ++ib; } }
        if (hi == 0) {
            const int t = chunk * 32 + r32, p = wid * 32 + r32;
#pragma unroll
            for (int s3 = 0; s3 < 3; ++s3) {
                if (sel[s3] >= 0) { const int rank = __hip_atomic_fetch_add(lcnt + h * NBLK + sel[s3], 1, __ATOMIC_RELAXED, __HIP_MEMORY_SCOPE_WORKGROUP); selb[p * 3 + s3] = (sel[s3] << 16) | rank; }
                else { selb[p * 3 + s3] = -1; LSE[((size_t)t * NH + h) * 4 + s3] = -INFINITY; }
            }
        }
        __syncthreads();
        if (tid < 256) { const int c = lcnt[tid]; if (c > 0) lbase[tid] = (int)atomicAdd(acnt + tid * 64, (unsigned)c); }
        __syncthreads();
        if (tid < 256) { const int hh = tid >> 5, t = chunk * 32 + (tid & 31);
#pragma unroll
            for (int s = 0; s < 3; ++s) { const int v2 = selb[tid * 3 + s]; if (v2 >= 0) { const int bk = hh * NBLK + (v2 >> 16); alist[(size_t)bk * S + lbase[bk] + (v2 & 0xffff)] = t | (s << 16); } } }
        __syncthreads();
    }
    __syncthreads();
    const bf16_t* UB = (const bf16_t*)(a.ws + WS_UB);
    bf16_t* MIX = (bf16_t*)(a.ws + WS_MIXIN);
    const float* cw = a.in[I_CONVW]; const float* cb = a.in[I_CONVB]; const float* lg = a.in[I_CLNG]; const float* lb = a.in[I_CLNB];
    LAS float* red = (LAS float*)(lds + MISC_OFF + 1024);
    const int ch = 2 * tid;
    f32x2 w[CONVW];
#pragma unroll
    for (int j = 0; j < CONVW; ++j) w[j] = *(const f32x2*)(cw + (size_t)j * DC + ch);
    const f32x2 bias = *(const f32x2*)(cb + ch);
    for (int tile = blockIdx.x; tile < S / 16; tile += gridDim.x) {
        const int t0 = tile * 16;
        f32x2 acc[16];
#pragma unroll
        for (int o = 0; o < 16; ++o) acc[o] = bias;
        unsigned uraw[46];
#pragma unroll
        for (int r = 0; r < 46; ++r) { const int t = t0 - 30 + r; uraw[r] = *(const unsigned*)(UB + (size_t)(t >= 0 ? t : 0) * DC + ch); }
        if (t0 < 30) {
#pragma unroll
            for (int r = 0; r < 30; ++r) uraw[r] = (t0 - 30 + r >= 0) ? uraw[r] : 0u;
        }
#pragma unroll
        for (int r = 0; r < 46; ++r) {
            const f32x2 u2 = (f32x2){bf_lo(uraw[r]), bf_hi(uraw[r])};
#pragma unroll
            for (int o = 0; o < 16; ++o) { const int j = r - o; if (j >= 0 && j < CONVW) acc[o] += w[j] * u2; }
        }
        float mean[16];
#define RED16(EXPR, DST) do { float rv[16]; _Pragma("unroll") for (int o = 0; o < 16; ++o) rv[o] = (EXPR); \
        _Pragma("unroll") for (int st = 0; st < 4; ++st) { const int m = 32 >> st, nv = 8 >> st; const bool up = (lane & m) != 0; \
            _Pragma("unroll") for (int v = 0; v < nv; ++v) { const float lo_ = rv[v], hi_ = rv[v + nv]; const float send = up ? lo_ : hi_; const float recv = __shfl_xor(send, m); rv[v] = (up ? hi_ : lo_) + recv; } } \
        float tot = rv[0]; tot += __shfl_xor(tot, 2); tot += __shfl_xor(tot, 1); \
        if ((lane & 3) == 0) (DST)[wid * 16 + (((lane >> 5) & 1) * 8 + ((lane >> 4) & 1) * 4 + ((lane >> 3) & 1) * 2 + ((lane >> 2) & 1))] = tot; } while (0)
        RED16(acc[o][0] + acc[o][1], red);
        __syncthreads();
#pragma unroll
        for (int o = 0; o < 16; ++o) { float s = 0.f;
#pragma unroll
            for (int w8 = 0; w8 < 8; ++w8) s += red[w8 * 16 + o];
            mean[o] = s * (1.f / DC); acc[o] -= mean[o]; }
        RED16(acc[o][0] * acc[o][0] + acc[o][1] * acc[o][1], red + 128);
#undef RED16
        __syncthreads();
        const f32x2 g2 = *(const f32x2*)(lg + ch), b2 = *(const f32x2*)(lb + ch);
#pragma unroll
        for (int o = 0; o < 16; ++o) { float s = 0.f;
#pragma unroll
            for (int w8 = 0; w8 < 8; ++w8) s += red[128 + w8 * 16 + o];
            const float rstd = 1.f / sqrtf(s * (1.f / DC) + LN_EPS);
            const f32x2 y = acc[o] * rstd * g2 + b2;
            const float o0 = y[0] * fast_sigmoid(y[0]), o1 = y[1] * fast_sigmoid(y[1]);
            *(unsigned*)(MIX + (size_t)(t0 + o) * DM + DA + ch) = cvt_pk_bf16(o0, o1); }
        __syncthreads();
    }
}

namespace att {
constexpr int QBLK = 32, KVBLK = 64;
constexpr float SCALE = 0.088388347648318440f;
constexpr int SHM_V = KVBLK * HD * 2, SHM_K = KVBLK * HD * 2;
constexpr int LDQ = DA, LDK = DA;
#define KSWZ(row, colB) ((row) * 256 + ((colB) ^ (((row) & 7) << 4)))
#define SBAR() __builtin_amdgcn_sched_barrier(0)
__device__ __forceinline__ int crow(int r, int hi) { return (r & 3) + 8 * (r >> 2) + 4 * hi; }
__device__ __forceinline__ void bias_mask(f32x16& p0, f32x16& p1, float dist0, float coef, bool MASK) {
#pragma unroll
    for (int r = 0; r < 16; ++r) { const float c = (float)((r & 3) + 8 * (r >> 2)); const float d0 = dist0 - c, d1 = dist0 - c - 32.f;
        p0[r] = fmaf(coef, d0, p0[r]); p1[r] = fmaf(coef, d1, p1[r]);
        if (MASK) { if (d0 < 0.f) p0[r] = -1e30f; if (d1 < 0.f) p1[r] = -1e30f; } }
}
__device__ __forceinline__ void partialSM(f32x16& p0, f32x16& p1, float& m_reg, float& mn, float& alpha) {
    constexpr float C = SCALE * 1.4426950408889634f;
    float pmax = p0[0];
#pragma unroll
    for (int r = 1; r < 16; ++r) pmax = fmaxf(pmax, p0[r]);
#pragma unroll
    for (int r = 0; r < 16; ++r) pmax = fmaxf(pmax, p1[r]);
    { auto rr = __builtin_amdgcn_permlane32_swap(__float_as_uint(pmax), __float_as_uint(pmax), false, false);
      pmax = fmaxf(__uint_as_float(rr[0]), __uint_as_float(rr[1])); }
    mn = fmaxf(m_reg, pmax); alpha = __builtin_amdgcn_exp2f((m_reg - mn) * C); m_reg = mn;
    const float mnC = -mn * C;
#pragma unroll
    for (int r = 0; r < 16; ++r) p0[r] = fmaf(p0[r], C, mnC);
#pragma unroll
    for (int r = 0; r < 16; ++r) p1[r] = fmaf(p1[r], C, mnC);
#pragma unroll
    for (int r = 0; r < 16; ++r) p0[r] = __builtin_amdgcn_exp2f(p0[r]);
}
__device__ __forceinline__ void finishSM(f32x16& p0, f32x16& p1, float alpha, float& l_reg, bf16x8& pa0, bf16x8& pa1, bf16x8& pa2, bf16x8& pa3) {
#pragma unroll
    for (int r = 0; r < 16; ++r) p1[r] = __builtin_amdgcn_exp2f(p1[r]);
    float ps = 0;
#pragma unroll
    for (int r = 0; r < 16; ++r) ps += p0[r];
#pragma unroll
    for (int r = 0; r < 16; ++r) ps += p1[r];
    { auto rr = __builtin_amdgcn_permlane32_swap(__float_as_uint(ps), __float_as_uint(ps), false, false);
      ps = __uint_as_float(rr[0]) + __uint_as_float(rr[1]); }
    l_reg = l_reg * alpha + ps;
#define PK4(P, BASE, OUT) do { unsigned a0 = cvt_pk_bf16(P[BASE + 0], P[BASE + 1]), a1 = cvt_pk_bf16(P[BASE + 2], P[BASE + 3]);   \
    unsigned b0 = cvt_pk_bf16(P[BASE + 4], P[BASE + 5]), b1 = cvt_pk_bf16(P[BASE + 6], P[BASE + 7]);                              \
    auto r0 = __builtin_amdgcn_permlane32_swap(a0, b0, false, false); auto r1 = __builtin_amdgcn_permlane32_swap(a1, b1, false, false); \
    u32x4 w = {r0[0], r1[0], r0[1], r1[1]}; OUT = *reinterpret_cast<bf16x8*>(&w); } while (0)
    PK4(p0, 0, pa0); PK4(p0, 8, pa1); PK4(p1, 0, pa2); PK4(p1, 8, pa3);
#undef PK4
}
__device__ __forceinline__ void qkt(f32x16& p0, f32x16& p1, const char* Ks, const bf16x8* qr, int r32, int hi) {
    p0 = f32x16{}; p1 = f32x16{};
#pragma unroll
    for (int d0 = 0; d0 < 8; ++d0) { const int cb = (d0 * 16 + hi * 8) * 2;
        bf16x8 b0 = *reinterpret_cast<const bf16x8*>(Ks + KSWZ(r32, cb));
        bf16x8 b1 = *reinterpret_cast<const bf16x8*>(Ks + KSWZ(32 + r32, cb));
        p0 = __builtin_amdgcn_mfma_f32_32x32x16_bf16(b0, qr[d0], p0, 0, 0, 0);
        p1 = __builtin_amdgcn_mfma_f32_32x32x16_bf16(b1, qr[d0], p1, 0, 0, 0); }
}
__device__ __forceinline__ int v_st(int k, int c) { const int kk = (k & ~0xC) | ((k & 4) << 1) | ((k & 8) >> 1); return ((kk >> 3) * 4 + (c >> 5)) * 512 + ((kk & 7) * 32 + (c & 31)) * 2; }
__device__ __forceinline__ int v_rd_base(int lane) { return ((lane & 3) << 3) | (((lane >> 2) & 3) << 6) | (((lane >> 4) & 1) << 5) | (((lane >> 5) & 1) << 8); }
constexpr int v_rd_off(int d0, int ks, int half) { return d0 * 512 + ks * 4096 + half * 2048; }
template <int OFF> __device__ __forceinline__ s16x4 tr_read(int vb) {
    s16x4 r; asm volatile("ds_read_b64_tr_b16 %0, %1 offset:%2" : "=&v"(r) : "v"(vb), "i"(OFF) : "memory"); return r;
}
template <int D0> __device__ __forceinline__ void pv_one(f32x16& od, int vb, bf16x8 pa0, bf16x8 pa1, bf16x8 pa2, bf16x8 pa3) {
    const s16x4 l0 = tr_read<v_rd_off(D0, 0, 0)>(vb), h0 = tr_read<v_rd_off(D0, 0, 1)>(vb), l1 = tr_read<v_rd_off(D0, 1, 0)>(vb), h1 = tr_read<v_rd_off(D0, 1, 1)>(vb);
    const s16x4 l2 = tr_read<v_rd_off(D0, 2, 0)>(vb), h2 = tr_read<v_rd_off(D0, 2, 1)>(vb), l3 = tr_read<v_rd_off(D0, 3, 0)>(vb), h3 = tr_read<v_rd_off(D0, 3, 1)>(vb);
    asm volatile("s_waitcnt lgkmcnt(0)" ::: "memory"); SBAR();
#define PK(L, H) (bf16x8){L[0], L[1], L[2], L[3], H[0], H[1], H[2], H[3]}
    od = __builtin_amdgcn_mfma_f32_32x32x16_bf16(pa0, PK(l0, h0), od, 0, 0, 0);
    od = __builtin_amdgcn_mfma_f32_32x32x16_bf16(pa1, PK(l1, h1), od, 0, 0, 0);
    od = __builtin_amdgcn_mfma_f32_32x32x16_bf16(pa2, PK(l2, h2), od, 0, 0, 0);
    od = __builtin_amdgcn_mfma_f32_32x32x16_bf16(pa3, PK(l3, h3), od, 0, 0, 0);
#undef PK
}
__device__ __forceinline__ void pv_d0(f32x16* o, int vb, bf16x8 pa0, bf16x8 pa1, bf16x8 pa2, bf16x8 pa3) {
    pv_one<0>(o[0], vb, pa0, pa1, pa2, pa3); pv_one<1>(o[1], vb, pa0, pa1, pa2, pa3); pv_one<2>(o[2], vb, pa0, pa1, pa2, pa3); pv_one<3>(o[3], vb, pa0, pa1, pa2, pa3);
}
__device__ __forceinline__ void attn_group(const bf16_t* __restrict__ QB, int trow, int dst, int h, int kblk, bool mask, int ntl,
                                           bf16_t* __restrict__ OP, float* __restrict__ LSEp, const char* K_lds, const char* V_lds, float* ws) {
    const int lane = threadIdx.x & 63, r32 = lane & 31, hi = lane >> 5;
    float* li_l = ws; float* al_l = ws + 32; int* dst_l = (int*)(ws + 64);
    if (hi == 0) dst_l[r32] = dst;
    float m_reg = -1e30f, l_reg = 0; f32x16 o[4] = {}; bf16x8 qr[8];
    const bf16_t* Qw = QB + (size_t)trow * LDQ + h * HD + hi * 8;
#pragma unroll
    for (int d0 = 0; d0 < 8; ++d0) qr[d0] = *reinterpret_cast<const bf16x8*>(Qw + d0 * 16);
    const float slope = __builtin_amdgcn_exp2f(-(float)(h + 1)), coef = -slope / SCALE;
    float distb = (float)(trow - kblk * BLK - 4 * hi);
    int vb = (int)(uintptr_t)V_lds + v_rd_base(lane);
#define RESC(a) do { if (__any((a) < 1.f)) { if (hi == 0) al_l[r32] = (a); asm volatile("s_waitcnt lgkmcnt(0)" ::: "memory"); \
    _Pragma("unroll") for (int d = 0; d < 4; ++d) _Pragma("unroll") for (int r = 0; r < 16; ++r) o[d][r] *= al_l[crow(r, hi)]; } } while (0)
    if (ntl == 4) {
        f32x16 pA0, pA1, pB0, pB1; float mnA, mnB, alA, alB; bf16x8 pa0, pa1, pa2, pa3;
        qkt(pA0, pA1, K_lds, qr, r32, hi); bias_mask(pA0, pA1, distb, coef, mask); partialSM(pA0, pA1, m_reg, mnA, alA);
        SBAR(); qkt(pB0, pB1, K_lds + SHM_K, qr, r32, hi); bias_mask(pB0, pB1, distb - 64.f, coef, mask);
        finishSM(pA0, pA1, alA, l_reg, pa0, pa1, pa2, pa3); SBAR();
        pv_d0(o, vb, pa0, pa1, pa2, pa3); partialSM(pB0, pB1, m_reg, mnB, alB);
        RESC(alB);
        SBAR(); qkt(pA0, pA1, K_lds + 2 * SHM_K, qr, r32, hi); bias_mask(pA0, pA1, distb - 128.f, coef, mask);
        finishSM(pB0, pB1, alB, l_reg, pa0, pa1, pa2, pa3); SBAR();
        pv_d0(o, vb + SHM_V, pa0, pa1, pa2, pa3); partialSM(pA0, pA1, m_reg, mnA, alA);
        RESC(alA);
        SBAR(); qkt(pB0, pB1, K_lds + 3 * SHM_K, qr, r32, hi); bias_mask(pB0, pB1, distb - 192.f, coef, mask);
        finishSM(pA0, pA1, alA, l_reg, pa0, pa1, pa2, pa3); SBAR();
        pv_d0(o, vb + 2 * SHM_V, pa0, pa1, pa2, pa3); partialSM(pB0, pB1, m_reg, mnB, alB);
        RESC(alB);
        finishSM(pB0, pB1, alB, l_reg, pa0, pa1, pa2, pa3); SBAR();
        pv_d0(o, vb + 3 * SHM_V, pa0, pa1, pa2, pa3);
    } else {
        for (int tl = 0; tl < ntl; ++tl) {
            f32x16 p0, p1; float mn, al; bf16x8 pa0, pa1, pa2, pa3;
            qkt(p0, p1, K_lds + tl * SHM_K, qr, r32, hi); bias_mask(p0, p1, distb, coef, mask);
            partialSM(p0, p1, m_reg, mn, al);
            RESC(al);
            finishSM(p0, p1, al, l_reg, pa0, pa1, pa2, pa3); SBAR();
            pv_d0(o, vb, pa0, pa1, pa2, pa3);
            distb -= 64.f; vb += SHM_V;
        }
    }
#undef RESC
    if (hi == 0) { li_l[r32] = l_reg; if (dst >= 0) LSEp[dst] = m_reg * (SCALE * 1.4426950408889634f) + __builtin_amdgcn_logf(l_reg); }
    asm volatile("s_waitcnt lgkmcnt(0)" ::: "memory");
#pragma unroll
    for (int rp = 0; rp < 8; ++rp) {
        const int ra = 2 * rp, rb = 2 * rp + 1; const int rowa = crow(ra, hi), rowb = crow(rb, hi);
        const float ia = __builtin_amdgcn_rcpf(li_l[rowa]), ib = __builtin_amdgcn_rcpf(li_l[rowb]);
        const int da = dst_l[rowa], db = dst_l[rowb];
        const bool odd = lane & 1;
        const int dd = odd ? db : da;
        bf16_t* orow = OP + (size_t)(dd < 0 ? 0 : dd) * HD + (r32 & ~1);
#pragma unroll
        for (int d0 = 0; d0 < 4; ++d0) { const float va = o[d0][ra] * ia, vb2 = o[d0][rb] * ib;
            const float send = odd ? va : vb2; const float recv = __shfl_xor(send, 1);
            const unsigned w = odd ? cvt_pk_bf16(recv, vb2) : cvt_pk_bf16(va, recv);
            if (dd >= 0) *(unsigned*)(orow + d0 * 32) = w; }
    }
}
}

__device__ __forceinline__ void phase_attention(const Args& a, LAS unsigned char* ldsl, char* lds, bool second) {
    const int tid = threadIdx.x, wid = tid >> 6, lane = tid & 63, r32 = lane & 31;
    const bf16_t* QB = (const bf16_t*)(a.ws + WS_QB); const bf16_t* KB = (const bf16_t*)(a.ws + WS_KB); const bf16_t* VB = (const bf16_t*)(a.ws + WS_VB);
    const unsigned* acnt = (const unsigned*)(a.ws + WS_CTL) + CW_ACNT;
    unsigned* aq = (unsigned*)(a.ws + WS_CTL) + (second ? CW_AQ + 64 : CW_AQ);
    const int* alist = (const int*)(a.ws + WS_ALIST);
    bf16_t* OP = (bf16_t*)(a.ws + WS_OPART); float* LSE = (float*)(a.ws + WS_LSE);
    volatile LAS int* pfx = (volatile LAS int*)(ldsl + MISC_OFF + 2048);
    char* K_lds = lds; char* V_lds = lds + 65536;
    float* wsc = (float*)(lds + MISC_OFF + 4096) + wid * 128;
    if (tid < 256) { const int ng = (int)((acnt[tid * 64] + 31u) >> 5); int v = (ng + 15) >> 4;
#pragma unroll
        for (int o = 1; o < 64; o <<= 1) { const int t = __shfl_up(v, o); if (lane >= o) v += t; }
        pfx[1 + tid] = v; if (lane == 63) pfx[300 + wid] = v; }
    __syncthreads();
    if (tid < 256) { int add = 0; for (int w = 0; w < wid; ++w) add += pfx[300 + w]; pfx[1 + tid] += add; if (tid == 0) pfx[0] = 0; }
    if (tid == 0) pfx[310] = (int)atomicAdd(aq, 1u);
    __syncthreads();
    const int nsel = pfx[256], nitems = 256 + nsel;
    for (;;) {
        const int it = pfx[310];
        __syncthreads();
        if (it >= nitems) break;
        if (tid == 0) pfx[310] = (int)atomicAdd(aq, 1u);
        int h, kb, g0, g1, b = 0; bool mask;
        if (it < nsel) {
#pragma unroll
            for (int s = 128; s >= 1; s >>= 1) { if (pfx[b + s] <= it) b += s; }
            b = __builtin_amdgcn_readfirstlane(b);
            const int k = __builtin_amdgcn_readfirstlane(it - pfx[b]); h = b >> 5; kb = b & 31; mask = false;
            const int ng = (int)((acnt[b * 64] + 31u) >> 5); g0 = 16 * k; g1 = (g0 + 16 < ng) ? g0 + 16 : ng;
        } else { const int j = it - nsel; h = j >> 5; kb = j & 31; mask = true; g0 = 0; g1 = 8; }
        { const bf16_t* Kh = KB + (size_t)kb * BLK * DA + h * HD; const bf16_t* Vh = VB + (size_t)kb * BLK * DA + h * HD;
          const int sr = tid >> 4, sc = (tid & 15) * 8;
          bf16x8 kv[8], vv[8];
#pragma unroll
          for (int j = 0; j < 8; ++j) { kv[j] = *(const bf16x8*)(Kh + (size_t)(sr + 32 * j) * DA + sc); vv[j] = *(const bf16x8*)(Vh + (size_t)(sr + 32 * j) * DA + sc); }
#pragma unroll
          for (int j = 0; j < 8; ++j) { const int row = sr + 32 * j, tl = row >> 6, rr = row & 63;
              *(bf16x8*)(K_lds + tl * att::SHM_K + KSWZ(rr, sc * 2)) = kv[j]; *(bf16x8*)(V_lds + tl * att::SHM_V + att::v_st(rr, sc)) = vv[j]; } }
        __syncthreads();
        const int cnt = mask ? 0 : (int)acnt[b * 64];
        for (int g = g0 + wid; g < g1; g += 8) {
            int trow, dst, ntl = 4;
            if (mask) { trow = kb * BLK + g * 32 + r32; dst = (trow * NH + h) * 4 + 3; ntl = (g >> 1) + 1; }
            else { const int ei = g * 32 + r32; const bool valid = ei < cnt; const int ent = alist[(size_t)b * S + (valid ? ei : 0)];
                trow = ent & 0xffff; dst = valid ? (trow * NH + h) * 4 + (ent >> 16) : -1; }
            att::attn_group(QB, trow, dst, h, kb, mask, ntl, OP, LSE, K_lds, V_lds, wsc);
        }
    }
}

__device__ __forceinline__ void phase_attn_combine(const Args& a) {
    const int tid = threadIdx.x, wid = tid >> 6, lane = tid & 63;
    const bf16_t* OP = (const bf16_t*)(a.ws + WS_OPART); const float* LSE = (const float*)(a.ws + WS_LSE); bf16_t* MIX = (bf16_t*)(a.ws + WS_MIXIN);
    const int gw = blockIdx.x * NWAVES + wid, ngw = gridDim.x * NWAVES;
    constexpr int U = 4;
    for (int p0 = gw * U; p0 < S * NH; p0 += ngw * U) {
        f32x4 l[U]; unsigned v[U][4];
#pragma unroll
        for (int u = 0; u < U; ++u) l[u] = *(const f32x4*)(LSE + (size_t)(p0 + u) * 4);
#pragma unroll
        for (int u = 0; u < U; ++u)
#pragma unroll
            for (int s = 0; s < 4; ++s) v[u][s] = (l[u][s] > -INFINITY) ? *(const unsigned*)(OP + ((size_t)(p0 + u) * 4 + s) * HD + 2 * lane) : 0u;
#pragma unroll
        for (int u = 0; u < U; ++u) {
            const float M = fmaxf(fmaxf(l[u][0], l[u][1]), fmaxf(l[u][2], l[u][3]));
            float ws = 0.f, o0 = 0.f, o1 = 0.f;
#pragma unroll
            for (int s = 0; s < 4; ++s) { const float wgt = __builtin_amdgcn_exp2f(l[u][s] - M); ws += wgt; o0 += wgt * bf_lo(v[u][s]); o1 += wgt * bf_hi(v[u][s]); }
            const float inv = 1.f / ws;
            const int p = p0 + u, t = p >> 3, h = p & 7;
            *(unsigned*)(MIX + (size_t)t * DM + h * HD + 2 * lane) = cvt_pk_bf16(o0 * inv, o1 * inv);
        }
    }
}

__device__ __forceinline__ void phase_ln1_router(const Args& a, LAS unsigned char* lds, bool dry) {
    const int tid = threadIdx.x, wid = __builtin_amdgcn_readfirstlane(tid >> 6), lane = tid & 63;
    const bf16_t* H = (const bf16_t*)(a.ws + WS_H1);
    const float* g1 = a.in[I_LN1G]; const float* b1 = a.in[I_LN1B]; const float* br = a.in[I_BR];
    unsigned* ecnt = (unsigned*)(a.ws + WS_CTL) + (dry ? CW_ECNT2 : CW_ECNT);
    int* tokrow = (int*)(a.ws + (dry ? WS_QB : WS_TOKROW)); float* gatel = (float*)(a.ws + (dry ? WS_KB : WS_GATE)); int* toklist = (int*)(a.ws + (dry ? WS_VB : WS_TOKLIST)); bf16_t* HB = (bf16_t*)(a.ws + (dry ? WS_MIXIN : WS_H1B)); unsigned char* H8 = a.ws + (dry ? WS_UB : WS_H8);
    const bf16_t* wimg = (const bf16_t*)(a.ws + WS_WRT);
    LAS int* ecl = (LAS int*)(lds + MISC_OFF + 4096);
    LAS int* ebase = ecl + 32;
    LAS int* rinfo = ebase + 32;
    LAS float* rgate = (LAS float*)(rinfo + 128);
    for (int rb = blockIdx.x * 2; rb < S / 16; rb += gridDim.x * 2) {
      if (tid < 32) ecl[tid] = 0;
      for (int pass = 0; pass < 2; ++pass) {
        asm volatile("" : "+s"(g1), "+s"(b1), "+s"(wimg), "+s"(H), "+s"(HB), "+s"(H8));
        const int row0 = (rb + pass) * 16 + wid * 2;
        __syncthreads();
#pragma unroll
        for (int r = 0; r < 2; ++r) {
            const bf16_t* hp = H + (size_t)(row0 + r) * DM;
            f32x4 hv[4][2]; float s = 0.f;
#pragma unroll
            for (int j = 0; j < 4; ++j) { const u32x4 hw = *(const u32x4*)(hp + (64 * j + lane) * 8);
                hv[j][0] = (f32x4){bf_lo(hw.x), bf_hi(hw.x), bf_lo(hw.y), bf_hi(hw.y)}; hv[j][1] = (f32x4){bf_lo(hw.z), bf_hi(hw.z), bf_lo(hw.w), bf_hi(hw.w)};
#pragma unroll
                for (int hh = 0; hh < 2; ++hh) s += (hv[j][hh][0] + hv[j][hh][1]) + (hv[j][hh][2] + hv[j][hh][3]); }
            const float mean = wave_sum(s) * (1.f / DM); float s2 = 0.f;
#pragma unroll
            for (int j = 0; j < 4; ++j)
#pragma unroll
                for (int hh = 0; hh < 2; ++hh) { hv[j][hh] -= mean; const f32x4 d = hv[j][hh]; s2 += (d[0] * d[0] + d[1] * d[1]) + (d[2] * d[2] + d[3] * d[3]); }
            const float rstd = 1.f / sqrtf(wave_sum(s2) * (1.f / DM) + LN_EPS);
            bf16_t* hb = HB + (size_t)(row0 + r) * DM;
            const int lr = wid * 2 + r;
#pragma unroll
            for (int j = 0; j < 4; ++j) {
#pragma unroll
                for (int hh = 0; hh < 2; ++hh) { const int k = (64 * j + lane) * 8 + 4 * hh; const f32x4 gg = *(const f32x4*)(g1 + k), bb = *(const f32x4*)(b1 + k);
                    hv[j][hh] = hv[j][hh] * rstd * gg + bb; }
                const f32x4 x0 = hv[j][0], x1 = hv[j][1];
                u32x4 w; w.x = cvt_pk_bf16(x0[0], x0[1]); w.y = cvt_pk_bf16(x0[2], x0[3]); w.z = cvt_pk_bf16(x1[0], x1[1]); w.w = cvt_pk_bf16(x1[2], x1[3]);
                *(u32x4*)(hb + (64 * j + lane) * 8) = w;
                u32x2 w8; w8.x = cvt4_fp8(x0[0] * SC_H, x0[1] * SC_H, x0[2] * SC_H, x0[3] * SC_H); w8.y = cvt4_fp8(x1[0] * SC_H, x1[1] * SC_H, x1[2] * SC_H, x1[3] * SC_H);
                *(u32x2*)(H8 + (size_t)(row0 + r) * DM + (64 * j + lane) * 8) = w8;
                u32x4 wl; wl.x = cvt_pk_bf16(x0[0] - bf_lo(w.x), x0[1] - bf_hi(w.x)); wl.y = cvt_pk_bf16(x0[2] - bf_lo(w.y), x0[3] - bf_hi(w.y));
                wl.z = cvt_pk_bf16(x1[0] - bf_lo(w.z), x1[1] - bf_hi(w.z)); wl.w = cvt_pk_bf16(x1[2] - bf_lo(w.w), x1[3] - bf_hi(w.w));
                const int off = lr * 4096 + (((64 * j + lane) ^ (lr & 15)) * 16);
                *(LAS u32x4*)(lds + off) = w; *(LAS u32x4*)(lds + 65536 + off) = wl;
                asm volatile("" ::: "memory"); }
        }
        __syncthreads();
        f32x4 lg0 = (f32x4){0.f, 0.f, 0.f, 0.f}, lg1 = lg0;
        { const int arow = lane & 15, kq = lane >> 4;
#pragma unroll
          for (int si = 0; si < 8; ++si) { const int ss = wid * 8 + si;
              const int aoff = arow * 4096 + (((4 * ss + kq) ^ arow) * 16);
              const bf16x8 ah = *(const LAS bf16x8*)(lds + aoff), al = *(const LAS bf16x8*)(lds + 65536 + aoff);
              const bf16_t* wp = wimg + ((size_t)(ss * 2) * 64 + lane) * 8;
              const bf16x8 bh0 = *(const bf16x8*)wp, bh1 = *(const bf16x8*)(wp + 512), bl0 = *(const bf16x8*)(wp + DM * NE), bl1 = *(const bf16x8*)(wp + DM * NE + 512);
              lg0 = __builtin_amdgcn_mfma_f32_16x16x32_bf16(ah, bh0, lg0, 0, 0, 0); lg0 = __builtin_amdgcn_mfma_f32_16x16x32_bf16(ah, bl0, lg0, 0, 0, 0); lg0 = __builtin_amdgcn_mfma_f32_16x16x32_bf16(al, bh0, lg0, 0, 0, 0);
              lg1 = __builtin_amdgcn_mfma_f32_16x16x32_bf16(ah, bh1, lg1, 0, 0, 0); lg1 = __builtin_amdgcn_mfma_f32_16x16x32_bf16(ah, bl1, lg1, 0, 0, 0); lg1 = __builtin_amdgcn_mfma_f32_16x16x32_bf16(al, bh1, lg1, 0, 0, 0); } }
        __syncthreads();
        { LAS float* part = (LAS float*)lds + wid * 512;
#pragma unroll
          for (int q = 0; q < 4; ++q) { const int prow = 4 * (lane >> 4) + q; part[prow * 32 + (lane & 15)] = lg0[q]; part[prow * 32 + 16 + (lane & 15)] = lg1[q]; } }
        __syncthreads();
        const int e = lane & 31, rr = lane >> 5;
        float lg = br[e];
#pragma unroll
        for (int w8 = 0; w8 < 8; ++w8) lg += ((const LAS float*)lds)[w8 * 512 + (wid * 2 + rr) * 32 + e];
        int sel_e[4]; float sel_v[4]; float gcur = lg;
#pragma unroll
        for (int s = 0; s < 4; ++s) { float bv = gcur; int bi = e;
#pragma unroll
            for (int o = 1; o < 32; o <<= 1) { const float ov = __shfl_xor(bv, o, 32); const int oi = __shfl_xor(bi, o, 32); if (ov > bv || (ov == bv && oi < bi)) { bv = ov; bi = oi; } }
            sel_e[s] = bi; sel_v[s] = bv; if (e == bi) gcur = -INFINITY; }
        float ex[4], es = 0.f;
#pragma unroll
        for (int s = 0; s < 4; ++s) { ex[s] = __expf(sel_v[s] - sel_v[0]); es += ex[s]; }
        const float einv = 1.f / es;
        const int lrow = pass * 16 + wid * 2 + rr;
#pragma unroll
        for (int s = 0; s < 4; ++s) { if (e == sel_e[s]) { const int rank = __hip_atomic_fetch_add(ecl + e, 1, __ATOMIC_RELAXED, __HIP_MEMORY_SCOPE_WORKGROUP);
            rinfo[lrow * 4 + s] = (e << 16) | rank; rgate[lrow * 4 + s] = ex[s] * einv; } }
      }
      VM_WAIT(); __syncthreads();
      if (tid < 32) { const int c = ecl[tid]; ebase[tid] = c > 0 ? (int)atomicAdd(ecnt + tid * 64, (unsigned)c) : 0; }
      __syncthreads();
      if (tid < 128) { const int cidx = tid, lrow = cidx >> 2; const int info = rinfo[cidx]; const int e = info >> 16;
          const int drow = e * ECAP + ebase[e] + (info & 0xffff); const int t = rb * 16 + lrow;
          gatel[drow] = rgate[cidx]; toklist[drow] = t; tokrow[(size_t)t * 4 + (cidx & 3)] = drow; }
      __syncthreads();
    }
}

__device__ __forceinline__ void phase_final(const Args& a) {
    const int tid = threadIdx.x, wid = tid >> 6, lane = tid & 63;
    const bf16_t* HB = (const bf16_t*)(a.ws + WS_H1B); const unsigned char* Y = a.ws + WS_XG; const int* tokrow = (const int*)(a.ws + WS_TOKROW);
    const float* g2 = a.in[I_LN2G]; const float* b2 = a.in[I_LN2B]; float* out = a.out;
    const int gw = blockIdx.x * NWAVES + wid, ngw = gridDim.x * NWAVES;
    typedef int i32x4 __attribute__((ext_vector_type(4)));
    constexpr int U = 2;
    for (int t0 = gw * U; t0 < S; t0 += ngw * U) {
        asm volatile("" : "+s"(g2), "+s"(b2), "+s"(out), "+s"(HB), "+s"(Y));
        i32x4 tr[U];
#pragma unroll
        for (int u = 0; u < U; ++u) tr[u] = *(const i32x4*)(tokrow + (size_t)(t0 + u) * 4);
        u32x4 hb[U][4]; u32x2 yr[U][4][4];
#pragma unroll
        for (int u = 0; u < U; ++u)
#pragma unroll
            for (int j = 0; j < 4; ++j) { const int k = (64 * j + lane) * 8; hb[u][j] = *(const u32x4*)(HB + (size_t)(t0 + u) * DM + k);
#pragma unroll
                for (int s = 0; s < 4; ++s) yr[u][j][s] = *(const u32x2*)(Y + (size_t)tr[u][s] * DM + k); }
#pragma unroll
        for (int u = 0; u < U; ++u) {
            const int t = t0 + u;
            f32x4 v[4][2]; float sm = 0.f;
#pragma unroll
            for (int j = 0; j < 4; ++j) { const u32x4 h4 = hb[u][j];
                f32x4 x0 = (f32x4){bf_lo(h4.x), bf_hi(h4.x), bf_lo(h4.y), bf_hi(h4.y)} * DN_ALPHA, x1 = (f32x4){bf_lo(h4.z), bf_hi(h4.z), bf_lo(h4.w), bf_hi(h4.w)} * DN_ALPHA;
#pragma unroll
                for (int s = 0; s < 4; ++s) { const u32x2 y = yr[u][j][s]; constexpr float iy = 1.f / SC_Y;
                    const f32x2 a0 = __builtin_amdgcn_cvt_pk_f32_fp8((int)y.x, false), a1 = __builtin_amdgcn_cvt_pk_f32_fp8((int)y.x, true), a2 = __builtin_amdgcn_cvt_pk_f32_fp8((int)y.y, false), a3 = __builtin_amdgcn_cvt_pk_f32_fp8((int)y.y, true);
                    x0[0] += a0[0] * iy; x0[1] += a0[1] * iy; x0[2] += a1[0] * iy; x0[3] += a1[1] * iy; x1[0] += a2[0] * iy; x1[1] += a2[1] * iy; x1[2] += a3[0] * iy; x1[3] += a3[1] * iy; }
                v[j][0] = x0; v[j][1] = x1; sm += (x0[0] + x0[1]) + (x0[2] + x0[3]) + (x1[0] + x1[1]) + (x1[2] + x1[3]); }
            const float mean = wave_sum(sm) * (1.f / DM); float s2 = 0.f;
#pragma unroll
            for (int j = 0; j < 4; ++j)
#pragma unroll
                for (int hh = 0; hh < 2; ++hh) { v[j][hh] -= mean; const f32x4 d = v[j][hh]; s2 += (d[0] * d[0] + d[1] * d[1]) + (d[2] * d[2] + d[3] * d[3]); }
            const float rstd = 1.f / sqrtf(wave_sum(s2) * (1.f / DM) + LN_EPS);
#pragma unroll
            for (int j = 0; j < 4; ++j)
#pragma unroll
                for (int hh = 0; hh < 2; ++hh) { const int k = (64 * j + lane) * 8 + 4 * hh; const f32x4 gg = *(const f32x4*)(g2 + k), bb = *(const f32x4*)(b2 + k);
                    *(f32x4*)(out + (size_t)t * DM + k) = v[j][hh] * rstd * gg + bb; }
        }
    }
}

__global__ void __launch_bounds__(NTHR, 2) hybrid_fwd(Args args) {
    extern __shared__ __attribute__((aligned(16))) unsigned char lds_raw[];
    LAS unsigned char* lds = (LAS unsigned char*)lds_raw;
    volatile LAS unsigned* MISC = (volatile LAS unsigned*)(lds + MISC_OFF);
    const int tid = threadIdx.x;
    if (tid < 64) MISC[tid] = 0u;
    __syncthreads();
    unsigned char* ws = args.ws;
    const int lo = args.ph_lo, hi = args.ph_hi;
    XcdBarrier bar; bar.bar = (unsigned*)(ws + WS_CTL) + CW_BAR; bar.x = 0; bar.st = nullptr;
    if (hi - lo > 1) bar = xcd_barrier_post((unsigned*)(ws + WS_CTL) + CW_BAR, MISC + 8);
#ifndef PH_MASK
#define PH_MASK 0x3ff
#endif
#define IN(k) (((PH_MASK >> (k)) & 1) && lo <= (k) && (k) < hi)
    volatile LAS int* cqb = (volatile LAS int*)(lds + MISC_OFF + 256);
#define SEAM(k) do { if (IN(k) && IN((k) + 1)) { if ((k) == 1) { cq_while_waiting(args, lds, cqb, (unsigned)gridDim.x, CQ_N); cq_drain(args, lds, cqb, CQ_N); } xcd_barrier(bar); } } while (0)

#ifndef PH_REPEAT
#define PH_REPEAT 0
#endif
#define REP(k) ((PH_REPEAT >> (k)) & 1)
#define RUN(k, ...) do { if (IN(k)) { __VA_ARGS__; if (REP(k)) { xcd_barrier(bar); __VA_ARGS__; } } } while (0)
    RUN(0, phase_convert(args, lds));
    SEAM(0);
    RUN(1, {
        { const int r = (int)(blockIdx.x >> 3) - (32 - CV_P1_WGS / 8);
          if (r >= 0) { constexpr int per = CV_P1 / CV_P1_WGS; const int k = r * 8 + (int)(blockIdx.x & 7); moe_convert_items(args, lds, k * per, per); __syncthreads(); } }
        pg8::DenseOrder So; So.init(S, INCOLS, gridDim.x, blockIdx.x, ws + WS_XB, ws + WS_WINT); So.q = (unsigned*)(ws + WS_CTL) + CW_GQ;
        pg8::EpiInProj E{(bf16_t*)(ws + WS_QB), (bf16_t*)(ws + WS_UB), (float*)(ws + WS_CTL + CTL_KSUM)};
        pg8::gemm_phase<pg8::EpiInProj, pg8::DenseOrder>(lds, So, E, (LAS int*)(lds + MISC_OFF + 4096));
    });
    SEAM(1);
    if (IN(2)) { phase_gate_conv(args, lds, false); if (REP(2)) { xcd_barrier(bar); phase_gate_conv(args, lds, true); } }
    SEAM(2);
    if (IN(3)) {
        { const int r = (int)(blockIdx.x >> 3) - (32 - CV_P3_WGS / 8);
          if (r >= 0) { constexpr int per = (TI_GU - CV_P1) / CV_P3_WGS; const int k = r * 8 + (int)(blockIdx.x & 7);
              { f32x4 vw[8]; for (int it = TI_WIN + k; it < TI_WIN + TI_WOUT; it += CV_P3_WGS) { const TItem ia = t_decode(args, it); t_load(ia, vw, tid); t_process(ia, vw, lds, tid); } }
              moe_convert_items(args, lds, CV_P1 + k * per, per); __syncthreads(); } }
        phase_attention(args, lds, (char*)lds_raw, false); if (REP(3)) { xcd_barrier(bar); phase_attention(args, lds, (char*)lds_raw, true); } }
    SEAM(3);
    RUN(4, phase_attn_combine(args));
    SEAM(4);
    RUN(5, {
        pg8::DenseOrder So; So.init(S, DM, gridDim.x, blockIdx.x, ws + WS_MIXIN, ws + WS_WOUTT); So.q = nullptr;
        pg8::EpiOutProj E{(const bf16_t*)(ws + WS_XB), (bf16_t*)(ws + WS_H1)};
        pg8::gemm_phase<pg8::EpiOutProj, pg8::DenseOrder>(lds, So, E, (LAS int*)(lds + MISC_OFF + 4096));
    });
    SEAM(5);
    if (IN(6)) { phase_ln1_router(args, lds, false); if (REP(6)) { xcd_barrier(bar); phase_ln1_router(args, lds, true); } }
    SEAM(6);
    if (IN(7) || IN(8)) {
        volatile LAS int* pfx = (volatile LAS int*)(lds + MISC_OFF + 512);
        if (tid < 64) { const unsigned* ecnt = (const unsigned*)(ws + WS_CTL) + CW_ECNT; int v = (tid < NE) ? (int)((ecnt[(tid & 31) * 64] + 255u) >> 8) : 0;
#pragma unroll
            for (int o = 1; o < 64; o <<= 1) { const int t = __shfl_up(v, o); if ((tid & 63) >= o) v += t; }
            if (tid < NE) { pfx[1 + tid] = v; pfx[40 + tid] = (int)ecnt[tid * 64]; } if (tid == 0) pfx[0] = 0; }
        __syncthreads();
        RUN(7, {
            { const int r = (int)(blockIdx.x >> 3) - (32 - CV_P7_WGS / 8);
              if (r >= 0) { constexpr int per = (TI_D + CV_P7_WGS - 1) / CV_P7_WGS; const int k = r * 8 + (int)(blockIdx.x & 7); const int f = k * per; const int n = (f + per <= TI_D) ? per : (TI_D > f ? TI_D - f : 0);
                  moe_convert_items(args, lds, TI_GU + f, n); __syncthreads(); } }
            pg8::MoeOrder So{pfx, 16, (int)gridDim.x, (int)blockIdx.x, (const char*)(ws + WS_H8), (const char*)(ws + WS_WGUT), 0, (size_t)4096 * 2048, (size_t)256 * 2048, (const int*)(ws + WS_TOKLIST), (unsigned)S, (unsigned*)(ws + WS_CTL) + CW_GQ + 16 * 64};
            pg8::EpiGateUp E{ws + WS_ACT, args.in[I_BGU]};
            pg8::gemm_phase<pg8::EpiGateUp, pg8::MoeOrder, true, true>(lds, So, E, (LAS int*)(lds + MISC_OFF + 4096));
        });
        SEAM(7);
        RUN(8, {
            pg8::MoeOrder So{pfx, 8, (int)gridDim.x, (int)blockIdx.x, (const char*)(ws + WS_ACT), (const char*)(ws + WS_WDT), 0, (size_t)2048 * 2048, (size_t)256 * 2048, (const int*)(ws + WS_IDLIST), (unsigned)(NE * ECAP), nullptr};
            pg8::EpiDown E{ws + WS_XG, args.in[I_BD], (const float*)(ws + WS_GATE)};
            pg8::gemm_phase<pg8::EpiDown, pg8::MoeOrder, true, true>(lds, So, E, (LAS int*)(lds + MISC_OFF + 4096));
        });
    }
    SEAM(8);
    RUN(9, phase_final(args));
#undef IN
#undef SEAM
}

extern "C" void kernel_launch(void* const* d_in, const int* in_sizes, int n_in, void* d_out, int out_size, void* d_ws, size_t ws_size, hipStream_t stream) {
    static int grid = 0;
    if (grid == 0) {
        if (n_in != 17 || in_sizes[0] != S * DM || out_size != S * DM || ws_size < WS_END) {
            fprintf(stderr, "kernel_launch: built for 17 inputs, x/out of %d floats, >= %zu bytes of workspace; got n_in %d, in0 %d, out %d, ws %zu; nothing launched\n", S * DM, (size_t)WS_END, n_in, n_in > 0 ? in_sizes[0] : -1, out_size, ws_size);
            grid = -1; return; }
        int dev = 0, cus = 0, per_cu = 0;
        if (hipGetDevice(&dev) != hipSuccess || hipDeviceGetAttribute(&cus, hipDeviceAttributeMultiprocessorCount, dev) != hipSuccess) { fprintf(stderr, "kernel_launch: device query failed\n"); grid = -1; return; }
        if (hipFuncSetAttribute((const void*)hybrid_fwd, hipFuncAttributeMaxDynamicSharedMemorySize, LDS_BYTES) != hipSuccess) { fprintf(stderr, "kernel_launch: hipFuncSetAttribute failed\n"); grid = -1; return; }
        if (hipOccupancyMaxActiveBlocksPerMultiprocessor(&per_cu, (const void*)hybrid_fwd, NTHR, LDS_BYTES) != hipSuccess || per_cu < 1)
            fprintf(stderr, "kernel_launch: note: occupancy query reports %d workgroups per CU\n", per_cu);
        (void)hipGetLastError();
        grid = cus;
    }
    if (grid < 0) return;
    if (hipMemsetAsync((char*)d_ws + WS_CTL, 0, CTL_ZERO_BYTES, stream) != hipSuccess) { fprintf(stderr, "kernel_launch: memset failed\n"); return; }
    Args a{};
    for (int i = 0; i < 17; ++i) a.in[i] = (const float*)d_in[i];
    a.out = (float*)d_out; a.ws = (unsigned char*)d_ws;
#if MK_N_LAUNCHES == 1
    a.ph_lo = 0; a.ph_hi = NPHASE;
    hipLaunchKernelGGL(hybrid_fwd, dim3(grid), dim3(NTHR), LDS_BYTES, stream, a);
#else
    for (int p = 0; p < NPHASE; ++p) { a.ph_lo = p; a.ph_hi = p + 1; hipLaunchKernelGGL(hybrid_fwd, dim3(grid), dim3(NTHR), LDS_BYTES, stream, a); }
#endif
    const hipError_t le = hipPeekAtLastError();
    if (le != hipSuccess) fprintf(stderr, "kernel_launch: launch failed: %s\n", hipGetErrorName(le));
}
```

```cpp
#include <hip/hip_runtime.h>
#include <cstdio>
#include <cstdint>

#ifndef MK_N_LAUNCHES
#define MK_N_LAUNCHES 1
#endif

#define GAS __attribute__((address_space(1)))
#define LAS __attribute__((address_space(3)))
typedef unsigned short bf16_t;
typedef short bf16x8 __attribute__((ext_vector_type(8)));
typedef short s16x4 __attribute__((ext_vector_type(4)));
typedef float f32x4 __attribute__((ext_vector_type(4)));
typedef float f32x2 __attribute__((ext_vector_type(2)));
typedef float f32x16 __attribute__((ext_vector_type(16)));
typedef unsigned u32x4 __attribute__((ext_vector_type(4)));
typedef unsigned u32x2 __attribute__((ext_vector_type(2)));

constexpr int S = 8192, DM = 2048, DA = 1024, DC = 1024, NH = 8, HD = 128, NBLK = 32, BLK = 256;
constexpr int NE = 32, DFF = 2048, INCOLS = 5120, CONVW = 31;
constexpr int ECAP = 8192;
constexpr float LN_EPS = 1e-5f;
constexpr float DN_ALPHA = 1.189207115002721f;
constexpr float SC_W = 64.f, SC_H = 8.f, SC_ACT = 4.f, SC_Y = 64.f;
constexpr int NWAVES = 8, NTHR = 512;
constexpr int NPHASE = 10;

constexpr size_t MiB = 1u << 20;
constexpr size_t WS_CTL = 0, CTL_ZERO_BYTES = 1 * MiB;
constexpr size_t WS_XB = 1 * MiB;
constexpr size_t WS_WINT = 33 * MiB;
constexpr size_t WS_WOUTT = 53 * MiB;
constexpr size_t WS_QB = 61 * MiB;
constexpr size_t WS_KB = 77 * MiB;
constexpr size_t WS_VB = 93 * MiB;
constexpr size_t WS_UB = 109 * MiB;
constexpr size_t WS_ALIST = 125 * MiB;
constexpr size_t WS_LSE = 133 * MiB;
constexpr size_t WS_OPART = 134 * MiB;
constexpr size_t WS_MIXIN = 198 * MiB;
constexpr size_t WS_H1 = 230 * MiB;
constexpr size_t WS_TOKROW = 294 * MiB;
constexpr size_t WS_GATE = 295 * MiB;
constexpr size_t WS_WGUT = 296 * MiB;
constexpr size_t WS_WDT = 808 * MiB;
constexpr size_t WS_XG = 1064 * MiB;
constexpr size_t WS_ACT = 2088 * MiB;
constexpr size_t WS_H1B = 3112 * MiB;
constexpr size_t WS_WRT = 3144 * MiB;
constexpr size_t WS_TOKLIST = 3145 * MiB;
constexpr size_t WS_H8 = 3146 * MiB;
constexpr size_t WS_IDLIST = 3162 * MiB;
constexpr size_t WS_END = 3163 * MiB;
constexpr int CW_BAR = 4096;
constexpr int CW_ECNT = 8192;
constexpr int CW_CQ = 12416, CW_READY = 12480;
constexpr int CW_GQ = 49152;
constexpr int CW_AQ = 12288;
constexpr int CW_ECNT2 = 10240, CW_ACNT2 = 32768;
constexpr int CW_ACNT = 16384;
constexpr size_t CTL_KSUM = 262144;

constexpr int RING_BYTES = 131072;
constexpr int MISC_OFF = RING_BYTES;
constexpr int LDS_BYTES = RING_BYTES + 16384;

__device__ __forceinline__ unsigned cvt_pk_bf16(float lo, float hi) { unsigned r; asm volatile("v_cvt_pk_bf16_f32 %0, %1, %2" : "=v"(r) : "v"(lo), "v"(hi)); return r; }
__device__ __forceinline__ unsigned cvt4_fp8(float a, float b, float c, float d) {
    a = __builtin_amdgcn_fmed3f(a, -448.f, 448.f); b = __builtin_amdgcn_fmed3f(b, -448.f, 448.f); c = __builtin_amdgcn_fmed3f(c, -448.f, 448.f); d = __builtin_amdgcn_fmed3f(d, -448.f, 448.f);
    int w = __builtin_amdgcn_cvt_pk_fp8_f32(a, b, 0, false); w = __builtin_amdgcn_cvt_pk_fp8_f32(c, d, w, true); return (unsigned)w; }
__device__ __forceinline__ float bf_lo(unsigned w) { return __builtin_bit_cast(float, w << 16); }
__device__ __forceinline__ float bf_hi(unsigned w) { return __builtin_bit_cast(float, w & 0xffff0000u); }
__device__ __forceinline__ float wave_sum(float v) {
#pragma unroll
    for (int o = 1; o < 64; o <<= 1) v += __shfl_xor(v, o);
    return v;
}
__device__ __forceinline__ float fast_sigmoid(float x) { return __builtin_amdgcn_rcpf(1.f + __builtin_amdgcn_exp2f(-x * 1.4426950408889634f)); }
#define VM_WAIT() asm volatile("s_waitcnt vmcnt(0)" ::: "memory")
#define LDS_WAIT() asm volatile("s_waitcnt lgkmcnt(0)" ::: "memory")

#define XB_TMO      128
#define XB_XCNT(j)  (256  + 64 * (j))
#define XB_XSUB(j)  (1280 + 64 * (j))
#define XB_XGEN(j)  (2304 + 64 * (j))
#define XB_TOP      3328
#define XB_TOPGEN   3392
#define XCD_BAR_WORDS 3456
#define XB_SPIN_CAP (1u << 18)
__device__ __forceinline__ unsigned xb_ld(unsigned* p)              { return __hip_atomic_load(p, __ATOMIC_RELAXED, __HIP_MEMORY_SCOPE_AGENT); }
__device__ __forceinline__ unsigned xb_add(unsigned* p, unsigned v) { return __hip_atomic_fetch_add(p, v, __ATOMIC_RELAXED, __HIP_MEMORY_SCOPE_AGENT); }
__device__ __forceinline__ unsigned xb_xcc_id() { return (unsigned)__builtin_amdgcn_s_getreg((3 << 11) | 20) & 0xFu; }
#define XB_SPIN(cond, bar) do { unsigned _sp = 0; while (cond) { __builtin_amdgcn_s_sleep(1); \
    if ((++_sp & 255u) == 0u) { if (xb_ld(&(bar)[XB_TMO])) break; if (_sp > XB_SPIN_CAP) { atomicAdd(&(bar)[XB_TMO], 1u); break; } } } } while (0)
struct XcdBarrier { unsigned* bar; unsigned x; volatile LAS unsigned* st; };
__device__ __forceinline__ XcdBarrier xcd_barrier_post(unsigned* bar, volatile LAS unsigned* st) {
    XcdBarrier b; b.bar = bar; b.x = xb_xcc_id(); b.st = st;
    if (threadIdx.x == 0) (void)xb_add(&bar[XB_XCNT(b.x)], 1u);
    return b;
}
__device__ __forceinline__ void xcd_barrier_complete(unsigned* bar, unsigned x, unsigned& nloc, unsigned& nx) {
    const unsigned G = gridDim.x * gridDim.y * gridDim.z;
    unsigned sum, cnt, mine, sp = 0u;
    for (;;) {
        sum = 0u; cnt = 0u; mine = 0u;
#pragma unroll
        for (unsigned j = 0; j < 16; ++j) { const unsigned c = xb_ld(&bar[XB_XCNT(j)]); sum += c; cnt += (c > 0u) ? 1u : 0u; mine = (j == x) ? c : mine; }
        if (sum == G) break;
        __builtin_amdgcn_s_sleep(1);
        if ((++sp & 255u) == 0u) { if (xb_ld(&bar[XB_TMO])) break; if (sp > XB_SPIN_CAP) { atomicAdd(&bar[XB_TMO], 1u); break; } }
    }
    nloc = mine > 0u ? mine : 1u; nx = cnt > 0u ? cnt : 1u;
}
__device__ __forceinline__ void xcd_barrier(const XcdBarrier& b) {
    asm volatile("s_waitcnt vmcnt(0)" ::: "memory");
    __syncthreads();
    if (threadIdx.x == 0) {
        unsigned* bar = b.bar;
        __builtin_amdgcn_s_waitcnt(0);
        unsigned nloc = b.st[0], nx = b.st[1];
        if (nloc == 0u) { xcd_barrier_complete(bar, b.x, nloc, nx); b.st[0] = nloc; b.st[1] = nx; }
        const unsigned old = xb_add(&bar[XB_XSUB(b.x)], 1u);
        const unsigned gen = old / nloc;
        if (old + 1u == (gen + 1u) * nloc) {
            __builtin_amdgcn_fence(__ATOMIC_RELEASE, "agent");
            asm volatile("s_waitcnt vmcnt(0)" ::: "memory");
            const unsigned og = xb_add(&bar[XB_TOP], 1u);
            const unsigned tg = og / nx;
            if (og + 1u == (tg + 1u) * nx) xb_add(&bar[XB_TOPGEN], 1u);
            else XB_SPIN(xb_ld(&bar[XB_TOPGEN]) == tg, bar);
            __builtin_amdgcn_fence(__ATOMIC_ACQUIRE, "agent");
            xb_add(&bar[XB_XGEN(b.x)], 1u);
            asm volatile("s_waitcnt vmcnt(0)" ::: "memory");
        } else {
            XB_SPIN(xb_ld(&bar[XB_XGEN(b.x)]) == gen, bar);
            __builtin_amdgcn_fence(__ATOMIC_ACQUIRE, "agent");
            asm volatile("s_waitcnt vmcnt(0)" ::: "memory");
        }
    }
    __syncthreads();
}

namespace pg8 {
constexpr int BM = 256, BK = 64, HALF = 128, HTB = HALF * BK * 2, STAGE_BYTES = 8 * HTB, NXCD = 8, WGM = 8;
constexpr int GK = 2048, S_ROWS = 8192;
__host__ __device__ __forceinline__ int lds_byte(int r, int c) { const int st = (r >> 4) * 2 + (c >> 5), rr = r & 15, cc = c & 31, ob = rr * 64 + cc * 2; return st * 1024 + (ob ^ (((ob >> 9) & 1) << 5)); }
__host__ __device__ __forceinline__ void stage_rc(int b, int& R, int& C) { const int st = b / 1024, sb = b % 1024, swz = sb ^ (((sb >> 9) & 1) << 5); R = (st >> 1) * 16 + swz / 64; C = (st & 1) * 32 + (swz % 64) / 2; }
__host__ __device__ __forceinline__ int perm32(int rho) { const int n = rho >> 4, i = rho & 15; return 8 * (i >> 2) + 4 * n + (i & 3); }

struct Unit { const char* A; const char* B; const int* tok; int pm, pn, e; int half; };
constexpr size_t TSTEP = (size_t)BM * GK * 2;

struct DenseOrder {
    int nM, nN, nwg, G, c; const char* A; const char* Bt; static constexpr unsigned maxrow = 1u;
    __device__ void init(int M, int N, int G_, int c_, const void* A_, const void* Bt_) { nM = M / BM; nN = N / BM; nwg = nM * nN; G = G_; c = c_; A = (const char*)A_; Bt = (const char*)Bt_; }
    unsigned* q;
    __device__ __forceinline__ bool decode(int L, Unit& u) const {
        if (L >= nwg) return false;
        int wgid = L; { const int q = nwg / NXCD, r = nwg % NXCD, xcd = wgid % NXCD, off = wgid / NXCD; wgid = (xcd < r ? xcd * (q + 1) : r * (q + 1) + (xcd - r) * q) + off; }
        const int nig = WGM * nN, gid = wgid / nig, fm = gid * WGM, gsz = (nM - fm) < WGM ? (nM - fm) : WGM;
        u.pm = fm + ((wgid % nig) % gsz); u.pn = (wgid % nig) / gsz; u.e = 0;
        u.A = A + (size_t)u.pm * TSTEP; u.B = Bt + (size_t)u.pn * TSTEP; u.tok = nullptr; return true;
    }
};
struct MoeOrder {
    const volatile LAS int* pfx; int npn, G, c; const char* A; const char* Bt; size_t a_es, b_es; size_t ts  ; const int* toklist; unsigned maxrow  ;
    unsigned* q;
    __device__ __forceinline__ bool decode(int L, Unit& u) const {
        const int total = pfx[NE] * npn; if (L >= total) return false;
        const int gm = L / npn, pn = L - gm * npn;
        int e = 0;
#pragma unroll
        for (int s = 16; s >= 1; s >>= 1) { if (pfx[e + s] <= gm) e += s; }
        e = __builtin_amdgcn_readfirstlane(e);
        const int mt = __builtin_amdgcn_readfirstlane(gm - pfx[e]);
        u.pm = mt; u.pn = pn; u.e = e; u.half = __builtin_amdgcn_readfirstlane((pfx[40 + e] - mt * BM) <= HALF ? 1 : 0);
        u.A = toklist ? A : A + (size_t)e * a_es + (size_t)mt * ts; u.B = Bt + (size_t)e * b_es + (size_t)pn * ts; u.tok = toklist ? toklist + (size_t)e * ECAP + mt * BM : nullptr; return true;
    }
};

typedef int v8i __attribute__((ext_vector_type(8)));
template <class Epi, class Sched, bool GATHER = false, bool FP8 = false>
__device__ __forceinline__ void gemm_phase(LAS unsigned char* lds, const Sched& S, const Epi& E, LAS int* tokl) {
    const int tid = threadIdx.x, wid = __builtin_amdgcn_readfirstlane(tid >> 6), lane = tid & 63, wr = wid >> 2, wc = wid & 3, fr = lane & 15, fq = lane >> 4;
    constexpr int K = FP8 ? GK / 2 : GK, nt = K / BK;
    unsigned vc[2][2], voffB[2];
#pragma unroll
    for (int i = 0; i < 2; ++i) { int R, C; stage_rc(tid * 16 + i * 8192, R, C); const int Rb = Epi::PERM ? ((R & ~31) + perm32(R & 31)) : R;
        voffB[i] = (unsigned)(Rb * K + C) * 2u;
#pragma unroll
        for (int h = 0; h < 2; ++h) vc[h][i] = (unsigned)((R + HALF * h) * K + C) * 2u; }
#define PG8_GATHER_OFFS(TOKPTR) do { int _tz = threadIdx.x; asm volatile("" : "+v"(_tz)); _Pragma("unroll") for (int _i = 0; _i < 2; ++_i) { int _R, _C; stage_rc(_tz * 16 + _i * 8192, _R, _C); \
        _Pragma("unroll") for (int _h = 0; _h < 2; ++_h) { unsigned _tk = (unsigned)(TOKPTR)[_R + HALF * _h]; _tk = _tk < S.maxrow ? _tk : S.maxrow - 1u; vc[_h][_i] = (_tk * K + (unsigned)_C) * 2u; } } } while (0)
    constexpr size_t kstep = (size_t)(BK * 2);
    constexpr size_t hstep = (size_t)HALF * K * 2;
    const unsigned ldsw = (unsigned)wid * 1024u;
    const int aoff = lds_byte(wr * 64 + fr, fq * 8), boff = lds_byte(wc * 32 + fr, fq * 8);
#define PG8_SA(b, h) (((b) * 2 + (h)) * HTB)
#define PG8_SB(b, h) ((4 + (b) * 2 + (h)) * HTB)
#define PG8_STAGE(bufoff, gbase, voff) do { _Pragma("unroll") for (int _i = 0; _i < 2; ++_i) \
        __builtin_amdgcn_global_load_lds((const unsigned*)((const char*)(gbase) + (voff)[_i]), (LAS unsigned*)(lds + (bufoff) + ldsw + _i * 8192), 16, 0, 0); } while (0)
#define PG8_LDA(dst, b, h) do { _Pragma("unroll") for (int m = 0; m < 4; ++m) _Pragma("unroll") for (int k = 0; k < 2; ++k) dst[m][k] = *(const LAS bf16x8*)(lds + PG8_SA(b, h) + aoff + m * 2048 + k * 1024); } while (0)
#define PG8_LDB(dst, b, h) do { _Pragma("unroll") for (int n = 0; n < 2; ++n) _Pragma("unroll") for (int k = 0; k < 2; ++k) dst[n][k] = *(const LAS bf16x8*)(lds + PG8_SB(b, h) + boff + n * 2048 + k * 1024); } while (0)
struct Frag2 { bf16x8 a, b; };
#define PG8_CAT(x) (Frag2{x[0], x[1]})
#define PG8_MMA(ai, bj, At, Bt) do { __builtin_amdgcn_s_setprio(1); _Pragma("unroll") for (int m = 0; m < 4; ++m) _Pragma("unroll") for (int n = 0; n < 2; ++n) { \
        if constexpr (FP8) acc[ai][bj][m][n] = __builtin_amdgcn_mfma_scale_f32_16x16x128_f8f6f4(__builtin_bit_cast(v8i, PG8_CAT(Bt[n])), __builtin_bit_cast(v8i, PG8_CAT(At[m])), acc[ai][bj][m][n], 0, 0, 0, 0x7f7f7f7f, 0, 0x7f7f7f7f); \
        else { _Pragma("unroll") for (int k = 0; k < 2; ++k) acc[ai][bj][m][n] = __builtin_amdgcn_mfma_f32_16x16x32_bf16(Bt[n][k], At[m][k], acc[ai][bj][m][n], 0, 0, 0); } } \
        __builtin_amdgcn_s_setprio(0); } while (0)
#define PG8_WAIT_V(n) asm volatile("s_waitcnt vmcnt(" #n ")" ::: "memory")
#define PG8_WAIT_L(n) asm volatile("s_waitcnt lgkmcnt(" #n ")" ::: "memory")
#define PG8_BAR __builtin_amdgcn_s_barrier()
#define PG8_SCHED __builtin_amdgcn_sched_barrier(0)
    const int label = blockIdx.x & 7; unsigned* qp = S.q + label * 64; const bool dyn = S.q != nullptr;
    volatile LAS int* qs = (volatile LAS int*)(tokl + 2 * BM);
    int jnxt;
    if (dyn) { if (tid == 0) qs[0] = (int)xb_add(qp, 2u); __syncthreads(); jnxt = qs[0] + 1; }
    else jnxt = (int)(blockIdx.x >> 3) + 1;
    Unit cur, nxt; int ui = 0;
    if (!S.decode((jnxt - 1) * 8 + label, cur)) return;
    if (!dyn) jnxt += 31;
    f32x4 acc[2][2][4][2];
#pragma unroll
    for (int a = 0; a < 2; ++a)
#pragma unroll
        for (int b = 0; b < 2; ++b)
#pragma unroll
            for (int m = 0; m < 4; ++m)
#pragma unroll
                for (int n = 0; n < 2; ++n) acc[a][b][m][n] = (f32x4){0.f, 0.f, 0.f, 0.f};
    bf16x8 At[4][2], B0[2][2], B1[2][2];
    const char* cA = cur.A; const char* cB = cur.B;
    LAS float* epl = (LAS float*)((LAS char*)tokl + 4096);
    int eb = 0;
    if constexpr (Epi::STAGE) { if (wid == 0) E.stage(cur, lane, epl); }
    if constexpr (GATHER) PG8_GATHER_OFFS(cur.tok);
    PG8_STAGE(PG8_SB(0, 0), cB, voffB); PG8_STAGE(PG8_SB(0, 1), cB + hstep, voffB); PG8_STAGE(PG8_SA(0, 0), cA, vc[0]); PG8_STAGE(PG8_SA(0, 1), cA, vc[1]);
    if (wr == 1) PG8_BAR;
    PG8_WAIT_V(2); PG8_BAR;
    PG8_STAGE(PG8_SB(1, 0), cB + kstep, voffB); PG8_STAGE(PG8_SA(1, 0), cA + kstep, vc[0]); PG8_STAGE(PG8_SB(1, 1), cB + hstep + kstep, voffB);
    PG8_WAIT_V(6); PG8_BAR;
    for (;;) {
        const bool has_next = S.decode(jnxt * 8 + label, nxt);
        unsigned jreq = 0u;
        if (dyn && tid == 0) jreq = xb_add(qp, 1u);
        const char* nA = has_next ? nxt.A : cA; const char* nB = has_next ? nxt.B : cB;
        if constexpr (GATHER) {
            if (has_next && wid == 0) __builtin_amdgcn_global_load_lds((const unsigned*)(nxt.tok + lane * 4), (LAS unsigned*)(tokl + ((ui + 1) & 1) * BM), 16, 0, 0);
        }
        const int nb = (eb == 2) ? 0 : eb + 1;
        if constexpr (Epi::STAGE) { if (has_next && wid == 0) E.stage(nxt, lane, epl + nb * 512); }
        if (GATHER && FP8 && cur.half != 0) {
            for (int t = 0; t < nt; t += 2) {
                const bool last = (t == nt - 2);
                const char* a1 = cA + (size_t)(t + 1) * kstep;
                const char* a2 = last ? nA : cA + (size_t)(t + 2) * kstep; const char* b2 = last ? nB : cB + (size_t)(t + 2) * kstep;
                const char* a3 = a2 + kstep; const char* b3 = b2 + kstep;
                PG8_LDB(B0, 0, 0); PG8_LDB(B1, 0, 1); PG8_SCHED; PG8_LDA(At, 0, 0); PG8_STAGE(PG8_SA(1, 1), a1, vc[1]);
                if constexpr (GATHER) { if (last && has_next) PG8_GATHER_OFFS(tokl + ((ui + 1) & 1) * BM); }
                if (dyn && last && tid == 0) { asm volatile("" : "+v"(jreq)); qs[1 + (ui & 1)] = (int)jreq; }
                PG8_WAIT_V(8); PG8_WAIT_L(0); PG8_BAR; PG8_MMA(0, 0, At, B0); PG8_MMA(0, 1, At, B1); PG8_BAR; PG8_SCHED;
                PG8_STAGE(PG8_SB(0, 0), b2, voffB); PG8_STAGE(PG8_SB(0, 1), b2 + hstep, voffB); PG8_STAGE(PG8_SA(0, 0), a2, vc[0]);
                PG8_WAIT_V(8); PG8_WAIT_L(0); PG8_BAR; asm volatile("s_nop 7\n\ts_nop 7" ::: "memory"); PG8_BAR; PG8_SCHED;
                PG8_LDB(B0, 1, 0); PG8_LDB(B1, 1, 1); PG8_SCHED; PG8_LDA(At, 1, 0); PG8_STAGE(PG8_SA(0, 1), a2, vc[1]);
                PG8_WAIT_V(8); PG8_WAIT_L(0); PG8_BAR; PG8_MMA(0, 0, At, B0); PG8_MMA(0, 1, At, B1); PG8_BAR; PG8_SCHED;
                PG8_STAGE(PG8_SB(1, 0), b3, voffB); PG8_STAGE(PG8_SB(1, 1), b3 + hstep, voffB); PG8_STAGE(PG8_SA(1, 0), a3, vc[0]);
                PG8_WAIT_V(8); PG8_WAIT_L(0); PG8_BAR; asm volatile("s_nop 7\n\ts_nop 7" ::: "memory"); PG8_BAR; PG8_SCHED;
            }
        } else {
            for (int t = 0; t < nt; t += 2) {
                const bool last = (t == nt - 2);
                const char* a1 = cA + (size_t)(t + 1) * kstep;
                const char* a2 = last ? nA : cA + (size_t)(t + 2) * kstep; const char* b2 = last ? nB : cB + (size_t)(t + 2) * kstep;
                const char* a3 = a2 + kstep; const char* b3 = b2 + kstep;
                PG8_LDB(B0, 0, 0); PG8_LDB(B1, 0, 1); PG8_SCHED; PG8_LDA(At, 0, 0); PG8_STAGE(PG8_SA(1, 1), a1, vc[1]);
                if constexpr (GATHER) { if (last && has_next) PG8_GATHER_OFFS(tokl + ((ui + 1) & 1) * BM); }
                if (dyn && last && tid == 0) { asm volatile("" : "+v"(jreq)); qs[1 + (ui & 1)] = (int)jreq; }
                PG8_WAIT_V(8); PG8_WAIT_L(0); PG8_BAR; PG8_MMA(0, 0, At, B0); PG8_MMA(0, 1, At, B1); PG8_BAR; PG8_SCHED;
                PG8_LDA(At, 0, 1); PG8_STAGE(PG8_SB(0, 0), b2, voffB); PG8_STAGE(PG8_SB(0, 1), b2 + hstep, voffB); PG8_STAGE(PG8_SA(0, 0), a2, vc[0]);
                PG8_WAIT_V(8); PG8_WAIT_L(0); PG8_BAR; PG8_MMA(1, 0, At, B0); PG8_MMA(1, 1, At, B1); PG8_BAR; PG8_SCHED;
                PG8_LDB(B0, 1, 0); PG8_LDB(B1, 1, 1); PG8_SCHED; PG8_LDA(At, 1, 0); PG8_STAGE(PG8_SA(0, 1), a2, vc[1]);
                PG8_WAIT_V(8); PG8_WAIT_L(0); PG8_BAR; PG8_MMA(0, 0, At, B0); PG8_MMA(0, 1, At, B1); PG8_BAR; PG8_SCHED;
                PG8_LDA(At, 1, 1); PG8_STAGE(PG8_SB(1, 0), b3, voffB); PG8_STAGE(PG8_SB(1, 1), b3 + hstep, voffB); PG8_STAGE(PG8_SA(1, 0), a3, vc[0]);
                PG8_WAIT_V(8); PG8_WAIT_L(0); PG8_BAR; PG8_MMA(1, 0, At, B0); PG8_MMA(1, 1, At, B1); PG8_BAR; PG8_SCHED;
            }
        }
        if (wr == 0) PG8_BAR;
        { int tz = threadIdx.x; asm volatile("" : "+v"(tz)); const int lz = tz & 63; E(acc, cur, wr, wc, lz & 15, lz >> 4, epl + eb * 512); }
        if (!has_next) break;
#pragma unroll
        for (int a = 0; a < 2; ++a)
#pragma unroll
            for (int b = 0; b < 2; ++b)
#pragma unroll
                for (int m = 0; m < 4; ++m)
#pragma unroll
                    for (int n = 0; n < 2; ++n) acc[a][b][m][n] = (f32x4){0.f, 0.f, 0.f, 0.f};
        jnxt = dyn ? qs[1 + (ui & 1)] : jnxt + 32;
        cur = nxt; cA = nA; cB = nB; ++ui; eb = nb;
        if (wr == 1) PG8_BAR;
    }
    PG8_WAIT_V(0);
    PG8_BAR;
#undef PG8_SA
#undef PG8_SB
#undef PG8_STAGE
#undef PG8_LDA
#undef PG8_LDB
#undef PG8_MMA
#undef PG8_CAT
#undef PG8_GATHER_OFFS
#undef PG8_WAIT_V
#undef PG8_WAIT_L
#undef PG8_BAR
#undef PG8_SCHED
}

struct EpiInProj {
    static constexpr bool PERM = true; static constexpr bool STAGE = false;
    bf16_t *Q, *U; float* ksum;
    __device__ __forceinline__ void operator()(const f32x4 (&acc)[2][2][4][2], const Unit& u, int wr, int wc, int fr, int fq, const LAS float* lb) const {
        const int row0 = u.pm * BM + wr * 64 + fr;
        if (u.pn < 12) {
            const int t = u.pn >> 2; bf16_t* base = Q + (size_t)t * ((WS_KB - WS_QB) / 2);
            const int col0 = (u.pn & 3) * 256 + wc * 32 + 8 * fq;
#pragma unroll
            for (int ai = 0; ai < 2; ++ai)
#pragma unroll
                for (int m = 0; m < 4; ++m) { bf16_t* rowp = base + (size_t)(row0 + ai * HALF + m * 16) * DA + col0;
#pragma unroll
                    for (int bj = 0; bj < 2; ++bj) { const f32x4 v0 = acc[ai][bj][m][0], v1 = acc[ai][bj][m][1];
                        u32x4 w; w.x = cvt_pk_bf16(v0[0], v0[1]); w.y = cvt_pk_bf16(v0[2], v0[3]); w.z = cvt_pk_bf16(v1[0], v1[1]); w.w = cvt_pk_bf16(v1[2], v1[3]);
                        *(u32x4*)(rowp + bj * HALF) = w; } }
            if (t == 1) {
#pragma unroll
                for (int bj = 0; bj < 2; ++bj)
#pragma unroll
                    for (int n = 0; n < 2; ++n) { f32x4 s = (f32x4){0.f, 0.f, 0.f, 0.f};
#pragma unroll
                        for (int ai = 0; ai < 2; ++ai)
#pragma unroll
                            for (int m = 0; m < 4; ++m) s += acc[ai][bj][m][n];
#pragma unroll
                        for (int e = 0; e < 4; ++e) { float v = s[e]; v += __shfl_xor(v, 1); v += __shfl_xor(v, 2); v += __shfl_xor(v, 4); v += __shfl_xor(v, 8);
                            if (fr == 0) atomicAdd(ksum + (size_t)u.pm * DA + col0 + bj * HALF + 4 * n + e, v); } }
            }
        } else {
            const int ch0 = (u.pn - 12) * 128 + wc * 32 + 8 * fq;
#pragma unroll
            for (int ai = 0; ai < 2; ++ai)
#pragma unroll
                for (int m = 0; m < 4; ++m) { bf16_t* rowp = U + (size_t)(row0 + ai * HALF + m * 16) * DC + ch0;
                    float o[8];
#pragma unroll
                    for (int n = 0; n < 2; ++n)
#pragma unroll
                        for (int e = 0; e < 4; ++e) o[n * 4 + e] = acc[ai][0][m][n][e] * fast_sigmoid(acc[ai][1][m][n][e]);
                    u32x4 w; w.x = cvt_pk_bf16(o[0], o[1]); w.y = cvt_pk_bf16(o[2], o[3]); w.z = cvt_pk_bf16(o[4], o[5]); w.w = cvt_pk_bf16(o[6], o[7]);
                    *(u32x4*)rowp = w; }
        }
    }
};
struct EpiOutProj {
    static constexpr bool PERM = true; static constexpr bool STAGE = false;
    const bf16_t* X; bf16_t* H;
    __device__ __forceinline__ void operator()(const f32x4 (&acc)[2][2][4][2], const Unit& u, int wr, int wc, int fr, int fq, const LAS float* lb) const {
        const int row0 = u.pm * BM + wr * 64 + fr, col0 = u.pn * BM + wc * 32 + 8 * fq;
#pragma unroll
        for (int ai = 0; ai < 2; ++ai)
#pragma unroll
            for (int m = 0; m < 4; ++m) { const size_t off = (size_t)(row0 + ai * HALF + m * 16) * DM + col0;
#pragma unroll
                for (int bj = 0; bj < 2; ++bj) { const u32x4 xw = *(const u32x4*)(X + off + bj * HALF);
                    const f32x4 x0 = (f32x4){bf_lo(xw.x), bf_hi(xw.x), bf_lo(xw.y), bf_hi(xw.y)}, x1 = (f32x4){bf_lo(xw.z), bf_hi(xw.z), bf_lo(xw.w), bf_hi(xw.w)};
                    const f32x4 v0 = x0 * DN_ALPHA + acc[ai][bj][m][0], v1 = x1 * DN_ALPHA + acc[ai][bj][m][1];
                    u32x4 w; w.x = cvt_pk_bf16(v0[0], v0[1]); w.y = cvt_pk_bf16(v0[2], v0[3]); w.z = cvt_pk_bf16(v1[0], v1[1]); w.w = cvt_pk_bf16(v1[2], v1[3]);
                    *(u32x4*)(H + off + bj * HALF) = w; } }
    }
};
struct EpiGateUp {
    static constexpr bool PERM = true; static constexpr bool STAGE = true;
    __device__ __forceinline__ void stage(const Unit& u, int lane, LAS float* dst) const {
        const float* src = bias + (size_t)u.e * 4096 + u.pn * 128 + (lane & 31) * 4 + (lane >> 5) * 2048;
        __builtin_amdgcn_global_load_lds((const unsigned*)src, (LAS unsigned*)dst, 16, 0, 0); }
    unsigned char* ACT; const float* bias;
    __device__ __forceinline__ void operator()(const f32x4 (&acc)[2][2][4][2], const Unit& u, int wr, int wc, int fr, int fq, const LAS float* lb) const {
        const int row0 = u.pm * BM + wr * 64 + fr, ch0 = u.pn * 128 + wc * 32 + 8 * fq;
        const LAS float* bg = lb + wc * 32 + 8 * fq;
        f32x4 bgv[2], buv[2];
#pragma unroll
        for (int n = 0; n < 2; ++n) { bgv[n] = *(const LAS f32x4*)(bg + 4 * n); buv[n] = *(const LAS f32x4*)(bg + 128 + 4 * n); }
        unsigned char* base = ACT + (size_t)u.e * ECAP * DFF;
        constexpr float inv = 1.f / (SC_H * SC_W);
#pragma unroll
        for (int ai = 0; ai < 2; ++ai)
#pragma unroll
            for (int m = 0; m < 4; ++m) { unsigned char* rowp = base + (size_t)(row0 + ai * HALF + m * 16) * DFF + ch0;
                float o[8];
#pragma unroll
                for (int n = 0; n < 2; ++n)
#pragma unroll
                    for (int e = 0; e < 4; ++e) { float g = acc[ai][0][m][n][e] * inv + bgv[n][e], uu = acc[ai][1][m][n][e] * inv + buv[n][e];
                        g = fminf(g, 7.f); uu = fminf(fmaxf(uu, -7.f), 7.f);
                        o[n * 4 + e] = (uu + 1.f) * (g * fast_sigmoid(1.702f * g)) * SC_ACT; }
                u32x2 w; w.x = cvt4_fp8(o[0], o[1], o[2], o[3]); w.y = cvt4_fp8(o[4], o[5], o[6], o[7]);
                *(u32x2*)rowp = w; }
    }
};
struct EpiDown {
    static constexpr bool PERM = true; static constexpr bool STAGE = true;
    __device__ __forceinline__ void stage(const Unit& u, int lane, LAS float* dst) const {
        __builtin_amdgcn_global_load_lds((const unsigned*)(bias + (size_t)u.e * DM + u.pn * BM + lane * 4), (LAS unsigned*)dst, 16, 0, 0);
        __builtin_amdgcn_global_load_lds((const unsigned*)(gate + (size_t)u.e * ECAP + u.pm * BM + lane * 4), (LAS unsigned*)(dst + 256), 16, 0, 0); }
    unsigned char* Y; const float* bias; const float* gate;
    __device__ __forceinline__ void operator()(const f32x4 (&acc)[2][2][4][2], const Unit& u, int wr, int wc, int fr, int fq, const LAS float* lb) const {
        const int row0 = u.pm * BM + wr * 64 + fr, col0 = u.pn * BM + wc * 32 + 8 * fq;
        const LAS float* bb = lb + wc * 32 + 8 * fq;
        unsigned char* base = Y + (size_t)u.e * ECAP * DM; const LAS float* gp = lb + 256 - u.pm * BM;
        constexpr float inv = 1.f / (SC_ACT * SC_W);
#pragma unroll
        for (int bj = 0; bj < 2; ++bj) { const f32x4 b0 = *(const LAS f32x4*)(bb + bj * HALF), b1 = *(const LAS f32x4*)(bb + bj * HALF + 4);
#pragma unroll
            for (int ai = 0; ai < 2; ++ai)
#pragma unroll
                for (int m = 0; m < 4; ++m) { const int row = row0 + ai * HALF + m * 16; const float gt = gp[row] * SC_Y;
                    const f32x4 v0 = (acc[ai][bj][m][0] * inv + b0) * gt, v1 = (acc[ai][bj][m][1] * inv + b1) * gt;
                    u32x2 w; w.x = cvt4_fp8(v0[0], v0[1], v0[2], v0[3]); w.y = cvt4_fp8(v1[0], v1[1], v1[2], v1[3]);
                    *(u32x2*)(base + (size_t)row * DM + col0 + bj * HALF) = w; }
            asm volatile("" ::: "memory"); }
    }
};
}

struct Args { const float* in[17]; float* out; unsigned char* ws; int ph_lo, ph_hi; };
enum { I_X = 0, I_WIN, I_CONVW, I_CONVB, I_CLNG, I_CLNB, I_WOUT, I_LN1G, I_LN1B, I_WR, I_BR, I_WGU, I_BGU, I_WD, I_BD, I_LN2G, I_LN2B };

__device__ __forceinline__ int rowmap(int mode, int n) {
    if (mode == 1) {
        if (n < 3072) return n;
        if (n < 4096) { const int c = n - 3072; return 3072 + (c >> 7) * 256 + (c & 127); }
        const int c = n - 4096; return 3072 + (c >> 7) * 256 + 128 + (c & 127);
    }
    if (mode == 2) {
        if (n < 2048) return (n >> 7) * 256 + (n & 127);
        const int c = n - 2048; return (c >> 7) * 256 + 128 + (c & 127);
    }
    return n;
}
struct TItem { const float* src; bf16_t* dst; int N, mode, k0, n0; };
constexpr int TI_WIN = 32 * 20, TI_WOUT = 32 * 8, TI_GU = 32 * 32 * 16, TI_D = 32 * 32 * 8, TI_ALL = TI_WIN + TI_WOUT + TI_GU + TI_D;
__device__ __forceinline__ TItem t_decode(const Args& a, int it) {
    TItem r;
    if (it < TI_WIN) { r.src = a.in[I_WIN]; r.dst = (bf16_t*)(a.ws + WS_WINT); r.N = INCOLS; r.mode = 1; r.k0 = (it / 20) * 64; r.n0 = (it % 20) * 256; return r; }
    it -= TI_WIN;
    if (it < TI_WOUT) { r.src = a.in[I_WOUT]; r.dst = (bf16_t*)(a.ws + WS_WOUTT); r.N = DM; r.mode = 0; r.k0 = (it / 8) * 64; r.n0 = (it % 8) * 256; return r; }
    it -= TI_WOUT;
    if (it < TI_GU) { const int e = it / 512, j = it % 512; r.src = a.in[I_WGU] + (size_t)e * 2048 * 4096; r.dst = (bf16_t*)(a.ws + WS_WGUT + (size_t)e * 4096 * 2048); r.N = 4096; r.mode = 2; r.k0 = (j / 32) * 128; r.n0 = (j % 32) * 128; return r; }
    it -= TI_GU;
    { const int e = it / 256, j = it % 256; r.src = a.in[I_WD] + (size_t)e * 2048 * 2048; r.dst = (bf16_t*)(a.ws + WS_WDT + (size_t)e * 2048 * 2048); r.N = 2048; r.mode = 0; r.k0 = (j / 16) * 128; r.n0 = (j % 16) * 128; return r; }
}
__device__ __forceinline__ void t_load(const TItem& it, f32x4 (&v)[8], int tid) {
    const int kq = tid >> 6, nl = tid & 63;
    const float* p = it.src + (size_t)(it.k0 + kq * 8) * it.N + it.n0 + 4 * nl;
#pragma unroll
    for (int i = 0; i < 8; ++i) v[i] = *(const f32x4*)(p + (size_t)i * it.N);
}
__device__ __forceinline__ void t_process(const TItem& it, const f32x4 (&v)[8], LAS unsigned char* scr, int tid) {
    const int kq = tid >> 6, nl = tid & 63;
#pragma unroll
    for (int j = 0; j < 4; ++j) { u32x4 w; w.x = cvt_pk_bf16(v[0][j], v[1][j]); w.y = cvt_pk_bf16(v[2][j], v[3][j]); w.z = cvt_pk_bf16(v[4][j], v[5][j]); w.w = cvt_pk_bf16(v[6][j], v[7][j]);
        *(LAS u32x4*)(scr + (4 * nl + j) * 128 + ((kq ^ (nl & 7)) * 16)) = w; }
    __syncthreads();
#pragma unroll
    for (int p = 0; p < 4; ++p) { const int r = tid + 512 * p, nn = r >> 3, ch = r & 7;
        const u32x4 w = *(const LAS u32x4*)(scr + nn * 128 + ((ch ^ ((nn >> 2) & 7)) * 16));
        const int row = rowmap(it.mode, it.n0 + nn);
        *(u32x4*)(it.dst + (size_t)row * 2048 + it.k0 + ch * 8) = w; }
    __syncthreads();
}
__device__ __forceinline__ void t8_load(const TItem& it, f32x4 (&v)[8], int tid) {
    const int kq = tid >> 5, nl = tid & 31;
    const float* p = it.src + (size_t)(it.k0 + kq * 8) * it.N + it.n0 + 4 * nl;
#pragma unroll
    for (int i = 0; i < 8; ++i) v[i] = __builtin_nontemporal_load((const f32x4*)(p + (size_t)i * it.N));
}
template <bool SYNC2 = true> __device__ __forceinline__ void t8_process(const TItem& it, const f32x4 (&v)[8], LAS unsigned char* scr, int tid) {
    const int kq = tid >> 5, nl = tid & 31;
#pragma unroll
    for (int j = 0; j < 4; ++j) { u32x2 w; w.x = cvt4_fp8(v[0][j] * SC_W, v[1][j] * SC_W, v[2][j] * SC_W, v[3][j] * SC_W); w.y = cvt4_fp8(v[4][j] * SC_W, v[5][j] * SC_W, v[6][j] * SC_W, v[7][j] * SC_W);
        *(LAS u32x2*)(scr + (4 * nl + j) * 128 + (((kq >> 1) ^ (nl & 7)) * 16) + (kq & 1) * 8) = w; }
    __syncthreads();
#pragma unroll
    for (int p = 0; p < 2; ++p) { const int r = tid + 512 * p, nn = r >> 3, ch = r & 7;
        const u32x4 w = *(const LAS u32x4*)(scr + nn * 128 + ((ch ^ ((nn >> 2) & 7)) * 16));
        const int row = rowmap(it.mode, it.n0 + nn);
        __builtin_nontemporal_store(w, (u32x4*)((unsigned char*)it.dst + (size_t)row * 2048 + it.k0 + ch * 16)); }
    if (SYNC2) __syncthreads();
}
constexpr int CQ_N = 0;
constexpr int CV_P1 = 10240, CV_P1_WGS = 128, CV_P7_WGS = 96, CV_P3_WGS = 128;
__device__ __forceinline__ void phase_convert(const Args& a, LAS unsigned char* lds) {
    const int tid = threadIdx.x, G = gridDim.x, c = blockIdx.x;
    { const f32x4* src = (const f32x4*)a.in[I_X]; u32x4* dst = (u32x4*)(a.ws + WS_XB); const size_t n8 = (size_t)S * DM / 8;
      const size_t step = (size_t)G * NTHR;
      for (size_t i0 = (size_t)c * NTHR + tid; i0 < n8; i0 += 4 * step) { f32x4 p[4], q[4];
#pragma unroll
          for (int u = 0; u < 4; ++u) { const size_t i = i0 + u * step; if (i < n8) { p[u] = __builtin_nontemporal_load(src + 2 * i); q[u] = __builtin_nontemporal_load(src + 2 * i + 1); } }
#pragma unroll
          for (int u = 0; u < 4; ++u) { const size_t i = i0 + u * step; if (i < n8) {
              u32x4 w; w.x = cvt_pk_bf16(p[u][0], p[u][1]); w.y = cvt_pk_bf16(p[u][2], p[u][3]); w.z = cvt_pk_bf16(q[u][0], q[u][1]); w.w = cvt_pk_bf16(q[u][2], q[u][3]); dst[i] = w; } } } }
    { int* idl = (int*)(a.ws + WS_IDLIST); for (int i = c * NTHR + tid; i < NE * ECAP; i += G * NTHR) idl[i] = i; }
    { const float* wr = a.in[I_WR]; bf16_t* img = (bf16_t*)(a.ws + WS_WRT);
      for (int idx = c * NTHR + tid; idx < DM * NE; idx += G * NTHR) { const int j = idx & 7, l = (idx >> 3) & 63, et = (idx >> 9) & 1, ss = idx >> 10;
          const float w = wr[(size_t)(32 * ss + 8 * (l >> 4) + j) * NE + 16 * et + (l & 15)];
          const unsigned hi = cvt_pk_bf16(w, 0.f) & 0xffffu; const float wl = w - bf_lo(hi);
          img[idx] = (bf16_t)hi; img[DM * NE + idx] = (bf16_t)(cvt_pk_bf16(wl, 0.f) & 0xffffu); } }
    f32x4 va[8], vb[8];
    constexpr int TI_BF = TI_WIN + TI_WOUT;
    for (int it = c; it < TI_WIN; it += G) { const TItem ia = t_decode(a, it); t_load(ia, va, tid); t_process(ia, va, lds, tid); }
    int it = TI_BF + TI_GU + c;
    constexpr int TI_ALL0 = TI_BF + TI_GU;
    if (it < TI_ALL0) { TItem ia = t_decode(a, it); t8_load(ia, va, tid);
        for (;;) {
            const int itb = it + G; TItem ib; const bool hb = itb < TI_ALL0; if (hb) { ib = t_decode(a, itb); t8_load(ib, vb, tid); }
            t8_process(ia, va, lds, tid);
            if (!hb) break;
            const int ita = itb + G; const bool ha = ita < TI_ALL0; if (ha) { ia = t_decode(a, ita); t8_load(ia, va, tid); }
            t8_process(ib, vb, lds, tid);
            if (!ha) break;
            it = ita;
        }
    }
}
__device__ __forceinline__ void moe_convert_items(const Args& a, LAS unsigned char* lds, int first, int n) {
    constexpr int TI_BF = TI_WIN + TI_WOUT;
    const int tid = threadIdx.x;
    f32x4 va[8], vb[8], vc[8];
    const int it0 = TI_BF + first, itend = TI_BF + first + n;
    TItem ia, ib, ic;
    if (it0 < itend) { ia = t_decode(a, it0); t8_load(ia, va, tid); }
    if (it0 + 1 < itend) { ib = t_decode(a, it0 + 1); t8_load(ib, vb, tid); }
    for (int it = it0; it < itend; it += 3) {
        if (it + 2 < itend) { ic = t_decode(a, it + 2); t8_load(ic, vc, tid); }
        t8_process<false>(ia, va, lds + ((it - it0) & 1) * 16384, tid);
        if (it + 1 >= itend) break;
        if (it + 3 < itend) { ia = t_decode(a, it + 3); t8_load(ia, va, tid); }
        t8_process<false>(ib, vb, lds + ((it - it0 + 1) & 1) * 16384, tid);
        if (it + 2 >= itend) break;
        if (it + 4 < itend) { ib = t_decode(a, it + 4); t8_load(ib, vb, tid); }
        t8_process<false>(ic, vc, lds + ((it - it0) & 1) * 16384, tid);
    }
    __syncthreads();
}
constexpr int CQ_CHUNK = 2, TI_MOE = TI_GU + TI_D;
__device__ __forceinline__ void cq_drain(const Args& a, LAS unsigned char* lds, volatile LAS int* bc, int limit) {
    unsigned* cq = (unsigned*)(a.ws + WS_CTL) + CW_CQ;
    for (;;) {
        if (threadIdx.x == 0) { int q = -1; if ((int)xb_ld(cq) < limit) { q = (int)xb_add(cq, CQ_CHUNK); if (q >= limit) q = -1; } bc[0] = q; }
        __syncthreads(); const int q = bc[0]; __syncthreads();
        if (q < 0) break;
        moe_convert_items(a, lds, q, CQ_CHUNK);
    }
}
__device__ __forceinline__ void cq_while_waiting(const Args& a, LAS unsigned char* lds, volatile LAS int* bc, unsigned target, int limit) {
    unsigned* cq = (unsigned*)(a.ws + WS_CTL) + CW_CQ; unsigned* ready = (unsigned*)(a.ws + WS_CTL) + CW_READY;
    __syncthreads();
    if (threadIdx.x == 0) (void)xb_add(ready, 1u);
    for (;;) {
        if (threadIdx.x == 0) { int q = -1; if (xb_ld(ready) + 2u < target && (int)xb_ld(cq) < limit) { q = (int)xb_add(cq, CQ_CHUNK); if (q >= limit) q = -1; } bc[0] = q; }
        __syncthreads(); const int q = bc[0]; __syncthreads();
        if (q < 0) break;
        moe_convert_items(a, lds, q, CQ_CHUNK);
    }
}

__device__ __forceinline__ void phase_gate_conv(const Args& a, LAS unsigned char* lds, bool dry) {
    const int tid = threadIdx.x, wid = __builtin_amdgcn_readfirstlane(tid >> 6), lane = tid & 63;
    const bf16_t* QB = (const bf16_t*)(a.ws + WS_QB);
    const float* ksum = (const float*)(a.ws + WS_CTL + CTL_KSUM);
    unsigned* acnt = (unsigned*)(a.ws + WS_CTL) + (dry ? CW_ACNT2 : CW_ACNT);
    int* alist = (int*)(a.ws + (dry ? WS_ACT : WS_ALIST));
    float* LSE = (float*)(a.ws + (dry ? WS_ACT + 16 * MiB : WS_LSE));
    LAS int* lcnt = (LAS int*)(lds + MISC_OFF + 4096);
    LAS int* lbase = lcnt + 256;
    LAS int* selb = lbase + 256;
    for (int chunk = blockIdx.x; chunk < S / 32; chunk += gridDim.x) {
        const int qb = chunk >> 3;
        const int h = wid;
        if (tid < 256) lcnt[tid] = 0;
        __syncthreads();
        const int r32 = lane & 31, hi = lane >> 5;
        const float* kp = ksum + (size_t)r32 * DA + h * HD + hi * 8;
        const bf16_t* qp = QB + (size_t)(chunk * 32 + r32) * DA + h * HD + hi * 8;
        f32x16 sc = {};
#pragma unroll
        for (int ss = 0; ss < 8; ++ss) {
            const f32x4 k0 = *(const f32x4*)(kp + ss * 16), k1 = *(const f32x4*)(kp + ss * 16 + 4);
            const bf16x8 qf = *(const bf16x8*)(qp + ss * 16);
            u32x4 ah, al;
            ah.x = cvt_pk_bf16(k0[0], k0[1]); ah.y = cvt_pk_bf16(k0[2], k0[3]); ah.z = cvt_pk_bf16(k1[0], k1[1]); ah.w = cvt_pk_bf16(k1[2], k1[3]);
            al.x = cvt_pk_bf16(k0[0] - bf_lo(ah.x), k0[1] - bf_hi(ah.x)); al.y = cvt_pk_bf16(k0[2] - bf_lo(ah.y), k0[3] - bf_hi(ah.y));
            al.z = cvt_pk_bf16(k1[0] - bf_lo(ah.z), k1[1] - bf_hi(ah.z)); al.w = cvt_pk_bf16(k1[2] - bf_lo(ah.w), k1[3] - bf_hi(ah.w));
            sc = __builtin_amdgcn_mfma_f32_32x32x16_bf16(__builtin_bit_cast(bf16x8, ah), qf, sc, 0, 0, 0);
            sc = __builtin_amdgcn_mfma_f32_32x32x16_bf16(__builtin_bit_cast(bf16x8, al), qf, sc, 0, 0, 0);
        }
        float v[16];
#pragma unroll
        for (int r = 0; r < 16; ++r) { const int nb = (r & 3) + 8 * (r >> 2) + 4 * hi; v[r] = nb < qb ? sc[r] : -INFINITY; }
        float tv[3]; int ti[3];
#pragma unroll
        for (int s3 = 0; s3 < 3; ++s3) { float bv = v[0]; int bi = 4 * hi;
#pragma unroll
            for (int r = 1; r < 16; ++r) { const int nb = (r & 3) + 8 * (r >> 2) + 4 * hi; if (v[r] > bv) { bv = v[r]; bi = nb; } }
            tv[s3] = bv; ti[s3] = bi;
#pragma unroll
            for (int r = 0; r < 16; ++r) { const int nb = (r & 3) + 8 * (r >> 2) + 4 * hi; if (nb == bi) v[r] = -INFINITY; } }
        float pv3[3]; int pi3[3];
#pragma unroll
        for (int s3 = 0; s3 < 3; ++s3) { pv3[s3] = __shfl_xor(tv[s3], 32); pi3[s3] = __shfl_xor(ti[s3], 32); }
        int sel[3]; { int ia = 0, ib = 0;
#pragma unroll
            for (int s3 = 0; s3 < 3; ++s3) { const float va = ia == 0 ? tv[0] : (ia == 1 ? tv[1] : tv[2]), vb = ib == 0 ? pv3[0] : (ib == 1 ? pv3[1] : pv3[2]);
                const int na = ia == 0 ? ti[0] : (ia == 1 ? ti[1] : ti[2]), nb2 = ib == 0 ? pi3[0] : (ib == 1 ? pi3[1] : pi3[2]);
                const bool ta = (va > vb) || (va == vb && na < nb2);
                const float bv = ta ? va : vb; sel[s3] = (bv == -INFINITY) ? -1 : (ta ? na : nb2);
                if (ta) ++ia; else ++ib; } }
        if (hi == 0) {
            const int t = chunk * 32 + r32, p = wid * 32 + r32;
#pragma unroll
            for (int s3 = 0; s3 < 3; ++s3) {
                if (sel[s3] >= 0) { const int rank = __hip_atomic_fetch_add(lcnt + h * NBLK + sel[s3], 1, __ATOMIC_RELAXED, __HIP_MEMORY_SCOPE_WORKGROUP); selb[p * 3 + s3] = (sel[s3] << 16) | rank; }
                else { selb[p * 3 + s3] = -1; LSE[((size_t)t * NH + h) * 4 + s3] = -INFINITY; }
            }
        }
        __syncthreads();
        if (tid < 256) { const int c = lcnt[tid]; if (c > 0) lbase[tid] = (int)atomicAdd(acnt + tid * 64, (unsigned)c); }
        __syncthreads();
        if (tid < 256) { const int hh = tid >> 5, t = chunk * 32 + (tid & 31);
#pragma unroll
            for (int s = 0; s < 3; ++s) { const int v2 = selb[tid * 3 + s]; if (v2 >= 0) { const int bk = hh * NBLK + (v2 >> 16); alist[(size_t)bk * S + lbase[bk] + (v2 & 0xffff)] = t | (s << 16); } } }
        __syncthreads();
    }
    __syncthreads();
    const bf16_t* UB = (const bf16_t*)(a.ws + WS_UB);
    bf16_t* MIX = (bf16_t*)(a.ws + WS_MIXIN);
    const float* cw = a.in[I_CONVW]; const float* cb = a.in[I_CONVB]; const float* lg = a.in[I_CLNG]; const float* lb = a.in[I_CLNB];
    LAS float* red = (LAS float*)(lds + MISC_OFF + 1024);
    const int ch = 2 * tid;
    f32x2 w[CONVW];
#pragma unroll
    for (int j = 0; j < CONVW; ++j) w[j] = *(const f32x2*)(cw + (size_t)j * DC + ch);
    const f32x2 bias = *(const f32x2*)(cb + ch);
    for (int tile = blockIdx.x; tile < S / 16; tile += gridDim.x) {
        const int t0 = tile * 16;
        f32x2 acc[16];
#pragma unroll
        for (int o = 0; o < 16; ++o) acc[o] = bias;
        unsigned uraw[46];
#pragma unroll
        for (int r = 0; r < 46; ++r) { const int t = t0 - 30 + r; uraw[r] = *(const unsigned*)(UB + (size_t)(t >= 0 ? t : 0) * DC + ch); }
        if (t0 < 30) {
#pragma unroll
            for (int r = 0; r < 30; ++r) uraw[r] = (t0 - 30 + r >= 0) ? uraw[r] : 0u;
        }
#pragma unroll
        for (int r = 0; r < 46; ++r) {
            const f32x2 u2 = (f32x2){bf_lo(uraw[r]), bf_hi(uraw[r])};
#pragma unroll
            for (int o = 0; o < 16; ++o) { const int j = r - o; if (j >= 0 && j < CONVW) acc[o] += w[j] * u2; }
        }
        float mean[16];
#define RED16(EXPR, DST) do { float rv[16]; _Pragma("unroll") for (int o = 0; o < 16; ++o) rv[o] = (EXPR); \
        _Pragma("unroll") for (int st = 0; st < 4; ++st) { const int m = 32 >> st, nv = 8 >> st; const bool up = (lane & m) != 0; \
            _Pragma("unroll") for (int v = 0; v < nv; ++v) { const float lo_ = rv[v], hi_ = rv[v + nv]; const float send = up ? lo_ : hi_; const float recv = __shfl_xor(send, m); rv[v] = (up ? hi_ : lo_) + recv; } } \
        float tot = rv[0]; tot += __shfl_xor(tot, 2); tot += __shfl_xor(tot, 1); \
        if ((lane & 3) == 0) (DST)[wid * 16 + (((lane >> 5) & 1) * 8 + ((lane >> 4) & 1) * 4 + ((lane >> 3) & 1) * 2 + ((lane >> 2) & 1))] = tot; } while (0)
        RED16(acc[o][0] + acc[o][1], red);
        __syncthreads();
#pragma unroll
        for (int o = 0; o < 16; ++o) { float s = 0.f;
#pragma unroll
            for (int w8 = 0; w8 < 8; ++w8) s += red[w8 * 16 + o];
            mean[o] = s * (1.f / DC); acc[o] -= mean[o]; }
        RED16(acc[o][0] * acc[o][0] + acc[o][1] * acc[o][1], red + 128);
#undef RED16
        __syncthreads();
        const f32x2 g2 = *(const f32x2*)(lg + ch), b2 = *(const f32x2*)(lb + ch);
#pragma unroll
        for (int o = 0; o < 16; ++o) { float s = 0.f;
#pragma unroll
            for (int w8 = 0; w8 < 8; ++w8) s += red[128 + w8 * 16 + o];
            const float rstd = 1.f / sqrtf(s * (1.f / DC) + LN_EPS);
            const f32x2 y = acc[o] * rstd * g2 + b2;
            const float o0 = y[0] * fast_sigmoid(y[0]), o1 = y[1] * fast_sigmoid(y[1]);
            *(unsigned*)(MIX + (size_t)(t0 + o) * DM + DA + ch) = cvt_pk_bf16(o0, o1); }
        __syncthreads();
    }
}

namespace att {
constexpr int QBLK = 32, KVBLK = 64;
constexpr float SCALE = 0.088388347648318440f;
constexpr int SHM_V = KVBLK * HD * 2, SHM_K = KVBLK * HD * 2;
constexpr int LDQ = DA, LDK = DA;
#define KSWZ(row, colB) ((row) * 256 + ((colB) ^ (((row) & 7) << 4)))
#define SBAR() __builtin_amdgcn_sched_barrier(0)
__device__ __forceinline__ int crow(int r, int hi) { return (r & 3) + 8 * (r >> 2) + 4 * hi; }
__device__ __forceinline__ void bias_mask(f32x16& p0, f32x16& p1, float dist0, float coef, bool MASK) {
#pragma unroll
    for (int r = 0; r < 16; ++r) { const float c = (float)((r & 3) + 8 * (r >> 2)); const float d0 = dist0 - c, d1 = dist0 - c - 32.f;
        p0[r] = fmaf(coef, d0, p0[r]); p1[r] = fmaf(coef, d1, p1[r]);
        if (MASK) { if (d0 < 0.f) p0[r] = -1e30f; if (d1 < 0.f) p1[r] = -1e30f; } }
}
__device__ __forceinline__ void partialSM(f32x16& p0, f32x16& p1, float& m_reg, float& mn, float& alpha) {
    constexpr float C = SCALE * 1.4426950408889634f;
    float pmax = p0[0];
#pragma unroll
    for (int r = 1; r < 16; ++r) pmax = fmaxf(pmax, p0[r]);
#pragma unroll
    for (int r = 0; r < 16; ++r) pmax = fmaxf(pmax, p1[r]);
    { auto rr = __builtin_amdgcn_permlane32_swap(__float_as_uint(pmax), __float_as_uint(pmax), false, false);
      pmax = fmaxf(__uint_as_float(rr[0]), __uint_as_float(rr[1])); }
    mn = fmaxf(m_reg, pmax); alpha = __builtin_amdgcn_exp2f((m_reg - mn) * C); m_reg = mn;
    const float mnC = -mn * C;
#pragma unroll
    for (int r = 0; r < 16; ++r) p0[r] = fmaf(p0[r], C, mnC);
#pragma unroll
    for (int r = 0; r < 16; ++r) p1[r] = fmaf(p1[r], C, mnC);
#pragma unroll
    for (int r = 0; r < 16; ++r) p0[r] = __builtin_amdgcn_exp2f(p0[r]);
}
__device__ __forceinline__ void finishSM(f32x16& p0, f32x16& p1, float alpha, float& l_reg, bf16x8& pa0, bf16x8& pa1, bf16x8& pa2, bf16x8& pa3) {
#pragma unroll
    for (int r = 0; r < 16; ++r) p1[r] = __builtin_amdgcn_exp2f(p1[r]);
    float ps = 0;
#pragma unroll
    for (int r = 0; r < 16; ++r) ps += p0[r];
#pragma unroll
    for (int r = 0; r < 16; ++r) ps += p1[r];
    { auto rr = __builtin_amdgcn_permlane32_swap(__float_as_uint(ps), __float_as_uint(ps), false, false);
      ps = __uint_as_float(rr[0]) + __uint_as_float(rr[1]); }
    l_reg = l_reg * alpha + ps;
#define PK4(P, BASE, OUT) do { unsigned a0 = cvt_pk_bf16(P[BASE + 0], P[BASE + 1]), a1 = cvt_pk_bf16(P[BASE + 2], P[BASE + 3]);   \
    unsigned b0 = cvt_pk_bf16(P[BASE + 4], P[BASE + 5]), b1 = cvt_pk_bf16(P[BASE + 6], P[BASE + 7]);                              \
    auto r0 = __builtin_amdgcn_permlane32_swap(a0, b0, false, false); auto r1 = __builtin_amdgcn_permlane32_swap(a1, b1, false, false); \
    u32x4 w = {r0[0], r1[0], r0[1], r1[1]}; OUT = *reinterpret_cast<bf16x8*>(&w); } while (0)
    PK4(p0, 0, pa0); PK4(p0, 8, pa1); PK4(p1, 0, pa2); PK4(p1, 8, pa3);
#undef PK4
}
__device__ __forceinline__ void qkt(f32x16& p0, f32x16& p1, const char* Ks, const bf16x8* qr, int r32, int hi) {
    p0 = f32x16{}; p1 = f32x16{};
#pragma unroll
    for (int d0 = 0; d0 < 8; ++d0) { const int cb = (d0 * 16 + hi * 8) * 2;
        bf16x8 b0 = *reinterpret_cast<const bf16x8*>(Ks + KSWZ(r32, cb));
        bf16x8 b1 = *reinterpret_cast<const bf16x8*>(Ks + KSWZ(32 + r32, cb));
        p0 = __builtin_amdgcn_mfma_f32_32x32x16_bf16(b0, qr[d0], p0, 0, 0, 0);
        p1 = __builtin_amdgcn_mfma_f32_32x32x16_bf16(b1, qr[d0], p1, 0, 0, 0); }
}
__device__ __forceinline__ int v_st(int k, int c) { const int kk = (k & ~0xC) | ((k & 4) << 1) | ((k & 8) >> 1); return ((kk >> 3) * 4 + (c >> 5)) * 512 + ((kk & 7) * 32 + (c & 31)) * 2; }
__device__ __forceinline__ int v_rd_base(int lane) { return ((lane & 3) << 3) | (((lane >> 2) & 3) << 6) | (((lane >> 4) & 1) << 5) | (((lane >> 5) & 1) << 8); }
constexpr int v_rd_off(int d0, int ks, int half) { return d0 * 512 + ks * 4096 + half * 2048; }
template <int OFF> __device__ __forceinline__ s16x4 tr_read(int vb) {
    s16x4 r; asm volatile("ds_read_b64_tr_b16 %0, %1 offset:%2" : "=&v"(r) : "v"(vb), "i"(OFF) : "memory"); return r;
}
template <int D0> __device__ __forceinline__ void pv_one(f32x16& od, int vb, bf16x8 pa0, bf16x8 pa1, bf16x8 pa2, bf16x8 pa3) {
    const s16x4 l0 = tr_read<v_rd_off(D0, 0, 0)>(vb), h0 = tr_read<v_rd_off(D0, 0, 1)>(vb), l1 = tr_read<v_rd_off(D0, 1, 0)>(vb), h1 = tr_read<v_rd_off(D0, 1, 1)>(vb);
    const s16x4 l2 = tr_read<v_rd_off(D0, 2, 0)>(vb), h2 = tr_read<v_rd_off(D0, 2, 1)>(vb), l3 = tr_read<v_rd_off(D0, 3, 0)>(vb), h3 = tr_read<v_rd_off(D0, 3, 1)>(vb);
    asm volatile("s_waitcnt lgkmcnt(0)" ::: "memory"); SBAR();
#define PK(L, H) (bf16x8){L[0], L[1], L[2], L[3], H[0], H[1], H[2], H[3]}
    od = __builtin_amdgcn_mfma_f32_32x32x16_bf16(pa0, PK(l0, h0), od, 0, 0, 0);
    od = __builtin_amdgcn_mfma_f32_32x32x16_bf16(pa1, PK(l1, h1), od, 0, 0, 0);
    od = __builtin_amdgcn_mfma_f32_32x32x16_bf16(pa2, PK(l2, h2), od, 0, 0, 0);
    od = __builtin_amdgcn_mfma_f32_32x32x16_bf16(pa3, PK(l3, h3), od, 0, 0, 0);
#undef PK
}
__device__ __forceinline__ void pv_d0(f32x16* o, int vb, bf16x8 pa0, bf16x8 pa1, bf16x8 pa2, bf16x8 pa3) {
    pv_one<0>(o[0], vb, pa0, pa1, pa2, pa3); pv_one<1>(o[1], vb, pa0, pa1, pa2, pa3); pv_one<2>(o[2], vb, pa0, pa1, pa2, pa3); pv_one<3>(o[3], vb, pa0, pa1, pa2, pa3);
}
__device__ __forceinline__ void attn_group(const bf16_t* __restrict__ QB, int trow, int dst, int h, int kblk, bool mask, int ntl,
                                           bf16_t* __restrict__ OP, float* __restrict__ LSEp, const char* K_lds, const char* V_lds, float* ws) {
    const int lane = threadIdx.x & 63, r32 = lane & 31, hi = lane >> 5;
    float* li_l = ws; float* al_l = ws + 32; int* dst_l = (int*)(ws + 64);
    if (hi == 0) dst_l[r32] = dst;
    float m_reg = -1e30f, l_reg = 0; f32x16 o[4] = {}; bf16x8 qr[8];
    const bf16_t* Qw = QB + (size_t)trow * LDQ + h * HD + hi * 8;
#pragma unroll
    for (int d0 = 0; d0 < 8; ++d0) qr[d0] = *reinterpret_cast<const bf16x8*>(Qw + d0 * 16);
    const float slope = __builtin_amdgcn_exp2f(-(float)(h + 1)), coef = -slope / SCALE;
    float distb = (float)(trow - kblk * BLK - 4 * hi);
    int vb = (int)(uintptr_t)V_lds + v_rd_base(lane);
#define RESC(a) do { if (__any((a) < 1.f)) { if (hi == 0) al_l[r32] = (a); asm volatile("s_waitcnt lgkmcnt(0)" ::: "memory"); \
    _Pragma("unroll") for (int d = 0; d < 4; ++d) _Pragma("unroll") for (int r = 0; r < 16; ++r) o[d][r] *= al_l[crow(r, hi)]; } } while (0)
    if (ntl == 4) {
        f32x16 pA0, pA1, pB0, pB1; float mnA, mnB, alA, alB; bf16x8 pa0, pa1, pa2, pa3;
        qkt(pA0, pA1, K_lds, qr, r32, hi); bias_mask(pA0, pA1, distb, coef, mask); partialSM(pA0, pA1, m_reg, mnA, alA);
        SBAR(); qkt(pB0, pB1, K_lds + SHM_K, qr, r32, hi); bias_mask(pB0, pB1, distb - 64.f, coef, mask);
        finishSM(pA0, pA1, alA, l_reg, pa0, pa1, pa2, pa3); SBAR();
        pv_d0(o, vb, pa0, pa1, pa2, pa3); partialSM(pB0, pB1, m_reg, mnB, alB);
        RESC(alB);
        SBAR(); qkt(pA0, pA1, K_lds + 2 * SHM_K, qr, r32, hi); bias_mask(pA0, pA1, distb - 128.f, coef, mask);
        finishSM(pB0, pB1, alB, l_reg, pa0, pa1, pa2, pa3); SBAR();
        pv_d0(o, vb + SHM_V, pa0, pa1, pa2, pa3); partialSM(pA0, pA1, m_reg, mnA, alA);
        RESC(alA);
        SBAR(); qkt(pB0, pB1, K_lds + 3 * SHM_K, qr, r32, hi); bias_mask(pB0, pB1, distb - 192.f, coef, mask);
        finishSM(pA0, pA1, alA, l_reg, pa0, pa1, pa2, pa3); SBAR();
        pv_d0(o, vb + 2 * SHM_V, pa0, pa1, pa2, pa3); partialSM(pB0, pB1, m_reg, mnB, alB);
        RESC(alB);
        finishSM(pB0, pB1, alB, l_reg, pa0, pa1, pa2, pa3); SBAR();
        pv_d0(o, vb + 3 * SHM_V, pa0, pa1, pa2, pa3);
    } else {
        for (int tl = 0; tl < ntl; ++tl) {
            f32x16 p0, p1; float mn, al; bf16x8 pa0, pa1, pa2, pa3;
            qkt(p0, p1, K_lds + tl * SHM_K, qr, r32, hi); bias_mask(p0, p1, distb, coef, mask);
            partialSM(p0, p1, m_reg, mn, al);
            RESC(al);
            finishSM(p0, p1, al, l_reg, pa0, pa1, pa2, pa3); SBAR();
            pv_d0(o, vb, pa0, pa1, pa2, pa3);
            distb -= 64.f; vb += SHM_V;
        }
    }
#undef RESC
    if (hi == 0) { li_l[r32] = l_reg; if (dst >= 0) LSEp[dst] = m_reg * (SCALE * 1.4426950408889634f) + __builtin_amdgcn_logf(l_reg); }
    asm volatile("s_waitcnt lgkmcnt(0)" ::: "memory");
#pragma unroll
    for (int rp = 0; rp < 8; ++rp) {
        const int ra = 2 * rp, rb = 2 * rp + 1; const int rowa = crow(ra, hi), rowb = crow(rb, hi);
        const float ia = __builtin_amdgcn_rcpf(li_l[rowa]), ib = __builtin_amdgcn_rcpf(li_l[rowb]);
        const int da = dst_l[rowa], db = dst_l[rowb];
        const bool odd = lane & 1;
        const int dd = odd ? db : da;
        bf16_t* orow = OP + (size_t)(dd < 0 ? 0 : dd) * HD + (r32 & ~1);
#pragma unroll
        for (int d0 = 0; d0 < 4; ++d0) { const float va = o[d0][ra] * ia, vb2 = o[d0][rb] * ib;
            const float send = odd ? va : vb2; const float recv = __shfl_xor(send, 1);
            const unsigned w = odd ? cvt_pk_bf16(recv, vb2) : cvt_pk_bf16(va, recv);
            if (dd >= 0) *(unsigned*)(orow + d0 * 32) = w; }
    }
}
}

__device__ __forceinline__ void phase_attention(const Args& a, LAS unsigned char* ldsl, char* lds, bool second) {
    const int tid = threadIdx.x, wid = tid >> 6, lane = tid & 63, r32 = lane & 31;
    const bf16_t* QB = (const bf16_t*)(a.ws + WS_QB); const bf16_t* KB = (const bf16_t*)(a.ws + WS_KB); const bf16_t* VB = (const bf16_t*)(a.ws + WS_VB);
    const unsigned* acnt = (const unsigned*)(a.ws + WS_CTL) + CW_ACNT;
    unsigned* aq = (unsigned*)(a.ws + WS_CTL) + (second ? CW_AQ + 64 : CW_AQ);
    const int* alist = (const int*)(a.ws + WS_ALIST);
    bf16_t* OP = (bf16_t*)(a.ws + WS_OPART); float* LSE = (float*)(a.ws + WS_LSE);
    volatile LAS int* pfx = (volatile LAS int*)(ldsl + MISC_OFF + 2048);
    char* K_lds = lds; char* V_lds = lds + 65536;
    float* wsc = (float*)(lds + MISC_OFF + 4096) + wid * 128;
    if (tid < 256) { const int ng = (int)((acnt[tid * 64] + 31u) >> 5); int v = (ng + 15) >> 4;
#pragma unroll
        for (int o = 1; o < 64; o <<= 1) { const int t = __shfl_up(v, o); if (lane >= o) v += t; }
        pfx[1 + tid] = v; if (lane == 63) pfx[300 + wid] = v; }
    __syncthreads();
    if (tid < 256) { int add = 0; for (int w = 0; w < wid; ++w) add += pfx[300 + w]; pfx[1 + tid] += add; if (tid == 0) pfx[0] = 0; }
    if (tid == 0) pfx[310] = (int)atomicAdd(aq, 1u);
    __syncthreads();
    const int nsel = pfx[256], nitems = 256 + nsel;
    for (;;) {
        const int it = pfx[310];
        __syncthreads();
        if (it >= nitems) break;
        if (tid == 0) pfx[310] = (int)atomicAdd(aq, 1u);
        int h, kb, g0, g1, b = 0; bool mask;
        if (it < nsel) {
#pragma unroll
            for (int s = 128; s >= 1; s >>= 1) { if (pfx[b + s] <= it) b += s; }
            b = __builtin_amdgcn_readfirstlane(b);
            const int k = __builtin_amdgcn_readfirstlane(it - pfx[b]); h = b >> 5; kb = b & 31; mask = false;
            const int ng = (int)((acnt[b * 64] + 31u) >> 5); g0 = 16 * k; g1 = (g0 + 16 < ng) ? g0 + 16 : ng;
        } else { const int j = it - nsel; h = j >> 5; kb = j & 31; mask = true; g0 = 0; g1 = 8; }
        { const bf16_t* Kh = KB + (size_t)kb * BLK * DA + h * HD; const bf16_t* Vh = VB + (size_t)kb * BLK * DA + h * HD;
          const int sr = tid >> 4, sc = (tid & 15) * 8;
          bf16x8 kv[8], vv[8];
#pragma unroll
          for (int j = 0; j < 8; ++j) { kv[j] = *(const bf16x8*)(Kh + (size_t)(sr + 32 * j) * DA + sc); vv[j] = *(const bf16x8*)(Vh + (size_t)(sr + 32 * j) * DA + sc); }
#pragma unroll
          for (int j = 0; j < 8; ++j) { const int row = sr + 32 * j, tl = row >> 6, rr = row & 63;
              *(bf16x8*)(K_lds + tl * att::SHM_K + KSWZ(rr, sc * 2)) = kv[j]; *(bf16x8*)(V_lds + tl * att::SHM_V + att::v_st(rr, sc)) = vv[j]; } }
        __syncthreads();
        const int cnt = mask ? 0 : (int)acnt[b * 64];
        for (int g = g0 + wid; g < g1; g += 8) {
            int trow, dst, ntl = 4;
            if (mask) { trow = kb * BLK + g * 32 + r32; dst = (trow * NH + h) * 4 + 3; ntl = (g >> 1) + 1; }
            else { const int ei = g * 32 + r32; const bool valid = ei < cnt; const int ent = alist[(size_t)b * S + (valid ? ei : 0)];
                trow = ent & 0xffff; dst = valid ? (trow * NH + h) * 4 + (ent >> 16) : -1; }
            att::attn_group(QB, trow, dst, h, kb, mask, ntl, OP, LSE, K_lds, V_lds, wsc);
        }
    }
}

__device__ __forceinline__ void phase_attn_combine(const Args& a) {
    const int tid = threadIdx.x, wid = tid >> 6, lane = tid & 63;
    const bf16_t* OP = (const bf16_t*)(a.ws + WS_OPART); const float* LSE = (const float*)(a.ws + WS_LSE); bf16_t* MIX = (bf16_t*)(a.ws + WS_MIXIN);
    const int gw = blockIdx.x * NWAVES + wid, ngw = gridDim.x * NWAVES;
    constexpr int U = 4;
    for (int p0 = gw * U; p0 < S * NH; p0 += ngw * U) {
        f32x4 l[U]; unsigned v[U][4];
#pragma unroll
        for (int u = 0; u < U; ++u) l[u] = *(const f32x4*)(LSE + (size_t)(p0 + u) * 4);
#pragma unroll
        for (int u = 0; u < U; ++u)
#pragma unroll
            for (int s = 0; s < 4; ++s) v[u][s] = (l[u][s] > -INFINITY) ? *(const unsigned*)(OP + ((size_t)(p0 + u) * 4 + s) * HD + 2 * lane) : 0u;
#pragma unroll
        for (int u = 0; u < U; ++u) {
            const float M = fmaxf(fmaxf(l[u][0], l[u][1]), fmaxf(l[u][2], l[u][3]));
            float ws = 0.f, o0 = 0.f, o1 = 0.f;
#pragma unroll
            for (int s = 0; s < 4; ++s) { const float wgt = __builtin_amdgcn_exp2f(l[u][s] - M); ws += wgt; o0 += wgt * bf_lo(v[u][s]); o1 += wgt * bf_hi(v[u][s]); }
            const float inv = 1.f / ws;
            const int p = p0 + u, t = p >> 3, h = p & 7;
            *(unsigned*)(MIX + (size_t)t * DM + h * HD + 2 * lane) = cvt_pk_bf16(o0 * inv, o1 * inv);
        }
    }
}

__device__ __forceinline__ void phase_ln1_router(const Args& a, LAS unsigned char* lds, bool dry) {
    const int tid = threadIdx.x, wid = __builtin_amdgcn_readfirstlane(tid >> 6), lane = tid & 63;
    const bf16_t* H = (const bf16_t*)(a.ws + WS_H1);
    const float* g1 = a.in[I_LN1G]; const float* b1 = a.in[I_LN1B]; const float* br = a.in[I_BR];
    unsigned* ecnt = (unsigned*)(a.ws + WS_CTL) + (dry ? CW_ECNT2 : CW_ECNT);
    int* tokrow = (int*)(a.ws + (dry ? WS_QB : WS_TOKROW)); float* gatel = (float*)(a.ws + (dry ? WS_KB : WS_GATE)); int* toklist = (int*)(a.ws + (dry ? WS_VB : WS_TOKLIST)); bf16_t* HB = (bf16_t*)(a.ws + (dry ? WS_MIXIN : WS_H1B)); unsigned char* H8 = a.ws + (dry ? WS_UB : WS_H8);
    const bf16_t* wimg = (const bf16_t*)(a.ws + WS_WRT);
    LAS int* ecl = (LAS int*)(lds + MISC_OFF + 4096);
    LAS int* ebase = ecl + 32;
    LAS int* rinfo = ebase + 32;
    LAS float* rgate = (LAS float*)(rinfo + 128);
    for (int rb = blockIdx.x * 2; rb < S / 16; rb += gridDim.x * 2) {
      if (tid < 32) ecl[tid] = 0;
      for (int pass = 0; pass < 2; ++pass) {
        asm volatile("" : "+s"(g1), "+s"(b1), "+s"(wimg), "+s"(H), "+s"(HB), "+s"(H8));
        const int row0 = (rb + pass) * 16 + wid * 2;
        __syncthreads();
        u32x4 hw2[2][4]; f32x4 ggv[4][2], bbv[4][2];
#pragma unroll
        for (int r = 0; r < 2; ++r)
#pragma unroll
            for (int j = 0; j < 4; ++j) hw2[r][j] = *(const u32x4*)(H + (size_t)(row0 + r) * DM + (64 * j + lane) * 8);
#pragma unroll
        for (int j = 0; j < 4; ++j)
#pragma unroll
            for (int hh = 0; hh < 2; ++hh) { const int k = (64 * j + lane) * 8 + 4 * hh; ggv[j][hh] = *(const f32x4*)(g1 + k); bbv[j][hh] = *(const f32x4*)(b1 + k); }
#pragma unroll
        for (int r = 0; r < 2; ++r) {
            f32x4 hv[4][2]; float s = 0.f;
#pragma unroll
            for (int j = 0; j < 4; ++j) { const u32x4 hw = hw2[r][j];
                hv[j][0] = (f32x4){bf_lo(hw.x), bf_hi(hw.x), bf_lo(hw.y), bf_hi(hw.y)}; hv[j][1] = (f32x4){bf_lo(hw.z), bf_hi(hw.z), bf_lo(hw.w), bf_hi(hw.w)};
#pragma unroll
                for (int hh = 0; hh < 2; ++hh) s += (hv[j][hh][0] + hv[j][hh][1]) + (hv[j][hh][2] + hv[j][hh][3]); }
            const float mean = wave_sum(s) * (1.f / DM); float s2 = 0.f;
#pragma unroll
            for (int j = 0; j < 4; ++j)
#pragma unroll
                for (int hh = 0; hh < 2; ++hh) { hv[j][hh] -= mean; const f32x4 d = hv[j][hh]; s2 += (d[0] * d[0] + d[1] * d[1]) + (d[2] * d[2] + d[3] * d[3]); }
            const float rstd = 1.f / sqrtf(wave_sum(s2) * (1.f / DM) + LN_EPS);
            bf16_t* hb = HB + (size_t)(row0 + r) * DM;
            const int lr = wid * 2 + r;
#pragma unroll
            for (int j = 0; j < 4; ++j) {
#pragma unroll
                for (int hh = 0; hh < 2; ++hh) hv[j][hh] = hv[j][hh] * rstd * ggv[j][hh] + bbv[j][hh];
                const f32x4 x0 = hv[j][0], x1 = hv[j][1];
                u32x4 w; w.x = cvt_pk_bf16(x0[0], x0[1]); w.y = cvt_pk_bf16(x0[2], x0[3]); w.z = cvt_pk_bf16(x1[0], x1[1]); w.w = cvt_pk_bf16(x1[2], x1[3]);
                *(u32x4*)(hb + (64 * j + lane) * 8) = w;
                u32x2 w8; w8.x = cvt4_fp8(x0[0] * SC_H, x0[1] * SC_H, x0[2] * SC_H, x0[3] * SC_H); w8.y = cvt4_fp8(x1[0] * SC_H, x1[1] * SC_H, x1[2] * SC_H, x1[3] * SC_H);
                *(u32x2*)(H8 + (size_t)(row0 + r) * DM + (64 * j + lane) * 8) = w8;
                u32x4 wl; wl.x = cvt_pk_bf16(x0[0] - bf_lo(w.x), x0[1] - bf_hi(w.x)); wl.y = cvt_pk_bf16(x0[2] - bf_lo(w.y), x0[3] - bf_hi(w.y));
                wl.z = cvt_pk_bf16(x1[0] - bf_lo(w.z), x1[1] - bf_hi(w.z)); wl.w = cvt_pk_bf16(x1[2] - bf_lo(w.w), x1[3] - bf_hi(w.w));
                const int off = lr * 4096 + (((64 * j + lane) ^ (lr & 15)) * 16);
                *(LAS u32x4*)(lds + off) = w; *(LAS u32x4*)(lds + 65536 + off) = wl;
                asm volatile("" ::: "memory"); }
        }
        __syncthreads();
        f32x4 lg0 = (f32x4){0.f, 0.f, 0.f, 0.f}, lg1 = lg0;
        { const int arow = lane & 15, kq = lane >> 4;
#pragma unroll
          for (int si = 0; si < 8; ++si) { const int ss = wid * 8 + si;
              const int aoff = arow * 4096 + (((4 * ss + kq) ^ arow) * 16);
              const bf16x8 ah = *(const LAS bf16x8*)(lds + aoff), al = *(const LAS bf16x8*)(lds + 65536 + aoff);
              const bf16_t* wp = wimg + ((size_t)(ss * 2) * 64 + lane) * 8;
              const bf16x8 bh0 = *(const bf16x8*)wp, bh1 = *(const bf16x8*)(wp + 512), bl0 = *(const bf16x8*)(wp + DM * NE), bl1 = *(const bf16x8*)(wp + DM * NE + 512);
              lg0 = __builtin_amdgcn_mfma_f32_16x16x32_bf16(ah, bh0, lg0, 0, 0, 0); lg0 = __builtin_amdgcn_mfma_f32_16x16x32_bf16(ah, bl0, lg0, 0, 0, 0); lg0 = __builtin_amdgcn_mfma_f32_16x16x32_bf16(al, bh0, lg0, 0, 0, 0);
              lg1 = __builtin_amdgcn_mfma_f32_16x16x32_bf16(ah, bh1, lg1, 0, 0, 0); lg1 = __builtin_amdgcn_mfma_f32_16x16x32_bf16(ah, bl1, lg1, 0, 0, 0); lg1 = __builtin_amdgcn_mfma_f32_16x16x32_bf16(al, bh1, lg1, 0, 0, 0); } }
        __syncthreads();
        { LAS float* part = (LAS float*)lds + wid * 512;
#pragma unroll
          for (int q = 0; q < 4; ++q) { const int prow = 4 * (lane >> 4) + q; part[prow * 32 + (lane & 15)] = lg0[q]; part[prow * 32 + 16 + (lane & 15)] = lg1[q]; } }
        __syncthreads();
        const int e = lane & 31, rr = lane >> 5;
        float lg = br[e];
#pragma unroll
        for (int w8 = 0; w8 < 8; ++w8) lg += ((const LAS float*)lds)[w8 * 512 + (wid * 2 + rr) * 32 + e];
        int sel_e[4]; float sel_v[4]; float gcur = lg;
#pragma unroll
        for (int s = 0; s < 4; ++s) { float bv = gcur; int bi = e;
#pragma unroll
            for (int o = 1; o < 32; o <<= 1) { const float ov = __shfl_xor(bv, o, 32); const int oi = __shfl_xor(bi, o, 32); if (ov > bv || (ov == bv && oi < bi)) { bv = ov; bi = oi; } }
            sel_e[s] = bi; sel_v[s] = bv; if (e == bi) gcur = -INFINITY; }
        float ex[4], es = 0.f;
#pragma unroll
        for (int s = 0; s < 4; ++s) { ex[s] = __expf(sel_v[s] - sel_v[0]); es += ex[s]; }
        const float einv = 1.f / es;
        const int lrow = pass * 16 + wid * 2 + rr;
#pragma unroll
        for (int s = 0; s < 4; ++s) { if (e == sel_e[s]) { const int rank = __hip_atomic_fetch_add(ecl + e, 1, __ATOMIC_RELAXED, __HIP_MEMORY_SCOPE_WORKGROUP);
            rinfo[lrow * 4 + s] = (e << 16) | rank; rgate[lrow * 4 + s] = ex[s] * einv; } }
      }
      VM_WAIT(); __syncthreads();
      if (tid < 32) { const int c = ecl[tid]; ebase[tid] = c > 0 ? (int)atomicAdd(ecnt + tid * 64, (unsigned)c) : 0; }
      __syncthreads();
      if (tid < 128) { const int cidx = tid, lrow = cidx >> 2; const int info = rinfo[cidx]; const int e = info >> 16;
          const int drow = e * ECAP + ebase[e] + (info & 0xffff); const int t = rb * 16 + lrow;
          gatel[drow] = rgate[cidx]; toklist[drow] = t; tokrow[(size_t)t * 4 + (cidx & 3)] = drow; }
      __syncthreads();
    }
}

__device__ __forceinline__ void phase_final(const Args& a) {
    const int tid = threadIdx.x, wid = tid >> 6, lane = tid & 63;
    const bf16_t* HB = (const bf16_t*)(a.ws + WS_H1B); const unsigned char* Y = a.ws + WS_XG; const int* tokrow = (const int*)(a.ws + WS_TOKROW);
    const float* g2 = a.in[I_LN2G]; const float* b2 = a.in[I_LN2B]; float* out = a.out;
    const int gw = blockIdx.x * NWAVES + wid, ngw = gridDim.x * NWAVES;
    typedef int i32x4 __attribute__((ext_vector_type(4)));
    constexpr int U = 2;
    for (int t0 = gw * U; t0 < S; t0 += ngw * U) {
        asm volatile("" : "+s"(g2), "+s"(b2), "+s"(out), "+s"(HB), "+s"(Y));
        i32x4 tr[U];
#pragma unroll
        for (int u = 0; u < U; ++u) tr[u] = *(const i32x4*)(tokrow + (size_t)(t0 + u) * 4);
        u32x4 hb[U][4]; u32x2 yr[U][4][4];
#pragma unroll
        for (int u = 0; u < U; ++u)
#pragma unroll
            for (int j = 0; j < 4; ++j) { const int k = (64 * j + lane) * 8; hb[u][j] = *(const u32x4*)(HB + (size_t)(t0 + u) * DM + k);
#pragma unroll
                for (int s = 0; s < 4; ++s) yr[u][j][s] = *(const u32x2*)(Y + (size_t)tr[u][s] * DM + k); }
#pragma unroll
        for (int u = 0; u < U; ++u) {
            const int t = t0 + u;
            f32x4 v[4][2]; float sm = 0.f;
#pragma unroll
            for (int j = 0; j < 4; ++j) { const u32x4 h4 = hb[u][j];
                f32x4 x0 = (f32x4){bf_lo(h4.x), bf_hi(h4.x), bf_lo(h4.y), bf_hi(h4.y)} * DN_ALPHA, x1 = (f32x4){bf_lo(h4.z), bf_hi(h4.z), bf_lo(h4.w), bf_hi(h4.w)} * DN_ALPHA;
#pragma unroll
                for (int s = 0; s < 4; ++s) { const u32x2 y = yr[u][j][s]; constexpr float iy = 1.f / SC_Y;
                    const f32x2 a0 = __builtin_amdgcn_cvt_pk_f32_fp8((int)y.x, false), a1 = __builtin_amdgcn_cvt_pk_f32_fp8((int)y.x, true), a2 = __builtin_amdgcn_cvt_pk_f32_fp8((int)y.y, false), a3 = __builtin_amdgcn_cvt_pk_f32_fp8((int)y.y, true);
                    x0[0] += a0[0] * iy; x0[1] += a0[1] * iy; x0[2] += a1[0] * iy; x0[3] += a1[1] * iy; x1[0] += a2[0] * iy; x1[1] += a2[1] * iy; x1[2] += a3[0] * iy; x1[3] += a3[1] * iy; }
                v[j][0] = x0; v[j][1] = x1; sm += (x0[0] + x0[1]) + (x0[2] + x0[3]) + (x1[0] + x1[1]) + (x1[2] + x1[3]); }
            const float mean = wave_sum(sm) * (1.f / DM); float s2 = 0.f;
#pragma unroll
            for (int j = 0; j < 4; ++j)
#pragma unroll
                for (int hh = 0; hh < 2; ++hh) { v[j][hh] -= mean; const f32x4 d = v[j][hh]; s2 += (d[0] * d[0] + d[1] * d[1]) + (d[2] * d[2] + d[3] * d[3]); }
            const float rstd = 1.f / sqrtf(wave_sum(s2) * (1.f / DM) + LN_EPS);
#pragma unroll
            for (int j = 0; j < 4; ++j)
#pragma unroll
                for (int hh = 0; hh < 2; ++hh) { const int k = (64 * j + lane) * 8 + 4 * hh; const f32x4 gg = *(const f32x4*)(g2 + k), bb = *(const f32x4*)(b2 + k);
                    *(f32x4*)(out + (size_t)t * DM + k) = v[j][hh] * rstd * gg + bb; }
        }
    }
}

__global__ void __launch_bounds__(NTHR, 2) hybrid_fwd(Args args) {
    extern __shared__ __attribute__((aligned(16))) unsigned char lds_raw[];
    LAS unsigned char* lds = (LAS unsigned char*)lds_raw;
    volatile LAS unsigned* MISC = (volatile LAS unsigned*)(lds + MISC_OFF);
    const int tid = threadIdx.x;
    if (tid < 64) MISC[tid] = 0u;
    __syncthreads();
    unsigned char* ws = args.ws;
    const int lo = args.ph_lo, hi = args.ph_hi;
    XcdBarrier bar; bar.bar = (unsigned*)(ws + WS_CTL) + CW_BAR; bar.x = 0; bar.st = nullptr;
    if (hi - lo > 1) bar = xcd_barrier_post((unsigned*)(ws + WS_CTL) + CW_BAR, MISC + 8);
#ifndef PH_MASK
#define PH_MASK 0x3ff
#endif
#define IN(k) (((PH_MASK >> (k)) & 1) && lo <= (k) && (k) < hi)
    volatile LAS int* cqb = (volatile LAS int*)(lds + MISC_OFF + 256);
#define SEAM(k) do { if (IN(k) && IN((k) + 1)) { if ((k) == 1) { cq_while_waiting(args, lds, cqb, (unsigned)gridDim.x, CQ_N); cq_drain(args, lds, cqb, CQ_N); } xcd_barrier(bar); } } while (0)

#ifndef PH_REPEAT
#define PH_REPEAT 0
#endif
#define REP(k) ((PH_REPEAT >> (k)) & 1)
#define RUN(k, ...) do { if (IN(k)) { __VA_ARGS__; if (REP(k)) { xcd_barrier(bar); __VA_ARGS__; } } } while (0)
    RUN(0, phase_convert(args, lds));
    SEAM(0);
    RUN(1, {
        { const int r = (int)(blockIdx.x >> 3) - (32 - CV_P1_WGS / 8);
          if (r >= 0) { constexpr int per = CV_P1 / CV_P1_WGS; const int k = r * 8 + (int)(blockIdx.x & 7); moe_convert_items(args, lds, k * per, per); __syncthreads(); } }
        pg8::DenseOrder So; So.init(S, INCOLS, gridDim.x, blockIdx.x, ws + WS_XB, ws + WS_WINT); So.q = (unsigned*)(ws + WS_CTL) + CW_GQ;
        pg8::EpiInProj E{(bf16_t*)(ws + WS_QB), (bf16_t*)(ws + WS_UB), (float*)(ws + WS_CTL + CTL_KSUM)};
        pg8::gemm_phase<pg8::EpiInProj, pg8::DenseOrder>(lds, So, E, (LAS int*)(lds + MISC_OFF + 4096));
    });
    SEAM(1);
    if (IN(2)) { phase_gate_conv(args, lds, false); if (REP(2)) { xcd_barrier(bar); phase_gate_conv(args, lds, true); } }
    SEAM(2);
    if (IN(3)) {
        { const int r = (int)(blockIdx.x >> 3) - (32 - CV_P3_WGS / 8);
          if (r >= 0) { constexpr int per = (TI_GU - CV_P1) / CV_P3_WGS; const int k = r * 8 + (int)(blockIdx.x & 7);
              { f32x4 vw[8]; for (int it = TI_WIN + k; it < TI_WIN + TI_WOUT; it += CV_P3_WGS) { const TItem ia = t_decode(args, it); t_load(ia, vw, tid); t_process(ia, vw, lds, tid); } }
              moe_convert_items(args, lds, CV_P1 + k * per, per); __syncthreads(); } }
        phase_attention(args, lds, (char*)lds_raw, false); if (REP(3)) { xcd_barrier(bar); phase_attention(args, lds, (char*)lds_raw, true); } }
    SEAM(3);
    RUN(4, phase_attn_combine(args));
    SEAM(4);
    RUN(5, {
        pg8::DenseOrder So; So.init(S, DM, gridDim.x, blockIdx.x, ws + WS_MIXIN, ws + WS_WOUTT); So.q = nullptr;
        pg8::EpiOutProj E{(const bf16_t*)(ws + WS_XB), (bf16_t*)(ws + WS_H1)};
        pg8::gemm_phase<pg8::EpiOutProj, pg8::DenseOrder>(lds, So, E, (LAS int*)(lds + MISC_OFF + 4096));
    });
    SEAM(5);
    if (IN(6)) { phase_ln1_router(args, lds, false); if (REP(6)) { xcd_barrier(bar); phase_ln1_router(args, lds, true); } }
    SEAM(6);
    if (IN(7) || IN(8)) {
        volatile LAS int* pfx = (volatile LAS int*)(lds + MISC_OFF + 512);
        if (tid < 64) { const unsigned* ecnt = (const unsigned*)(ws + WS_CTL) + CW_ECNT; int v = (tid < NE) ? (int)((ecnt[(tid & 31) * 64] + 255u) >> 8) : 0;
#pragma unroll
            for (int o = 1; o < 64; o <<= 1) { const int t = __shfl_up(v, o); if ((tid & 63) >= o) v += t; }
            if (tid < NE) { pfx[1 + tid] = v; pfx[40 + tid] = (int)ecnt[tid * 64]; } if (tid == 0) pfx[0] = 0; }
        __syncthreads();
        RUN(7, {
            { const int r = (int)(blockIdx.x >> 3) - (32 - CV_P7_WGS / 8);
              if (r >= 0) { constexpr int per = (TI_D + CV_P7_WGS - 1) / CV_P7_WGS; const int k = r * 8 + (int)(blockIdx.x & 7); const int f = k * per; const int n = (f + per <= TI_D) ? per : (TI_D > f ? TI_D - f : 0);
                  moe_convert_items(args, lds, TI_GU + f, n); __syncthreads(); } }
            pg8::MoeOrder So{pfx, 16, (int)gridDim.x, (int)blockIdx.x, (const char*)(ws + WS_H8), (const char*)(ws + WS_WGUT), 0, (size_t)4096 * 2048, (size_t)256 * 2048, (const int*)(ws + WS_TOKLIST), (unsigned)S, (unsigned*)(ws + WS_CTL) + CW_GQ + 16 * 64};
            pg8::EpiGateUp E{ws + WS_ACT, args.in[I_BGU]};
            pg8::gemm_phase<pg8::EpiGateUp, pg8::MoeOrder, true, true>(lds, So, E, (LAS int*)(lds + MISC_OFF + 4096));
        });
        SEAM(7);
        RUN(8, {
            pg8::MoeOrder So{pfx, 8, (int)gridDim.x, (int)blockIdx.x, (const char*)(ws + WS_ACT), (const char*)(ws + WS_WDT), 0, (size_t)2048 * 2048, (size_t)256 * 2048, (const int*)(ws + WS_IDLIST), (unsigned)(NE * ECAP), nullptr};
            pg8::EpiDown E{ws + WS_XG, args.in[I_BD], (const float*)(ws + WS_GATE)};
            pg8::gemm_phase<pg8::EpiDown, pg8::MoeOrder, true, true>(lds, So, E, (LAS int*)(lds + MISC_OFF + 4096));
        });
    }
    SEAM(8);
    RUN(9, phase_final(args));
#undef IN
#undef SEAM
}

extern "C" void kernel_launch(void* const* d_in, const int* in_sizes, int n_in, void* d_out, int out_size, void* d_ws, size_t ws_size, hipStream_t stream) {
    static int grid = 0;
    if (grid == 0) {
        if (n_in != 17 || in_sizes[0] != S * DM || out_size != S * DM || ws_size < WS_END) {
            fprintf(stderr, "kernel_launch: built for 17 inputs, x/out of %d floats, >= %zu bytes of workspace; got n_in %d, in0 %d, out %d, ws %zu; nothing launched\n", S * DM, (size_t)WS_END, n_in, n_in > 0 ? in_sizes[0] : -1, out_size, ws_size);
            grid = -1; return; }
        int dev = 0, cus = 0, per_cu = 0;
        if (hipGetDevice(&dev) != hipSuccess || hipDeviceGetAttribute(&cus, hipDeviceAttributeMultiprocessorCount, dev) != hipSuccess) { fprintf(stderr, "kernel_launch: device query failed\n"); grid = -1; return; }
        if (hipFuncSetAttribute((const void*)hybrid_fwd, hipFuncAttributeMaxDynamicSharedMemorySize, LDS_BYTES) != hipSuccess) { fprintf(stderr, "kernel_launch: hipFuncSetAttribute failed\n"); grid = -1; return; }
        if (hipOccupancyMaxActiveBlocksPerMultiprocessor(&per_cu, (const void*)hybrid_fwd, NTHR, LDS_BYTES) != hipSuccess || per_cu < 1)
            fprintf(stderr, "kernel_launch: note: occupancy query reports %d workgroups per CU\n", per_cu);
        (void)hipGetLastError();
        grid = cus;
    }
    if (grid < 0) return;
    if (hipMemsetAsync((char*)d_ws + WS_CTL, 0, CTL_ZERO_BYTES, stream) != hipSuccess) { fprintf(stderr, "kernel_launch: memset failed\n"); return; }
    Args a{};
    for (int i = 0; i < 17; ++i) a.in[i] = (const float*)d_in[i];
    a.out = (float*)d_out; a.ws = (unsigned char*)d_ws;
#if MK_N_LAUNCHES == 1
    a.ph_lo = 0; a.ph_hi = NPHASE;
    hipLaunchKernelGGL(hybrid_fwd, dim3(grid), dim3(NTHR), LDS_BYTES, stream, a);
#else
    for (int p = 0; p < NPHASE; ++p) { a.ph_lo = p; a.ph_hi = p + 1; hipLaunchKernelGGL(hybrid_fwd, dim3(grid), dim3(NTHR), LDS_BYTES, stream, a); }
#endif
    const hipError_t le = hipPeekAtLastError();
    if (le != hipSuccess) fprintf(stderr, "kernel_launch: launch failed: %s\n", hipGetErrorName(le));
}
```
